# Optimizing an MI355X kernel written in HIP

```python
import jax, jax.numpy as jnp
from jax import lax
import numpy as np

D_MODEL = 2048
BATCH = 4
SEQ = 2048
DEPTH = 4

CHUNK = 64
Q_BLOCK = 128
N_MIXERS = 2
N_MLA_LAYERS = (DEPTH + 1) // 2
N_FOX_LAYERS = DEPTH // 2

MLA_HEADS = 16
MLA_Q_LORA = 512
MLA_KV_LORA = 512
MLA_NOPE_DIM = 128
MLA_ROPE_DIM = 64
MLA_V_DIM = 128
ROPE_THETA = 10000.0

FOX_HEADS = 16
FOX_HEAD_DIM = D_MODEL // FOX_HEADS

D_FF = -(-8 * D_MODEL // (3 * 256)) * 256

DEEPNORM_ALPHA = (2 * DEPTH) ** 0.25
DEEPNORM_BETA = (8 * DEPTH) ** -0.25
LN_EPS = 1e-5
RMS_EPS = 1e-6

kernel_name = "hybrid_mla_fox_deepnorm_adaln_trunk"


def _layer_norm(x, g, b):
    xf = x.astype(jnp.float32)
    mu = jnp.mean(xf, axis=-1, keepdims=True)
    var = jnp.mean(jnp.square(xf - mu), axis=-1, keepdims=True)
    y = (xf - mu) * lax.rsqrt(var + LN_EPS)
    return (y * g.astype(jnp.float32) + b.astype(jnp.float32)).astype(x.dtype)


def _rms_norm(x, g):
    xf = x.astype(jnp.float32)
    y = xf * lax.rsqrt(jnp.mean(jnp.square(xf), axis=-1, keepdims=True) + RMS_EPS)
    return (y * g.astype(jnp.float32)).astype(x.dtype)


def _rope_cos_sin(positions, dtype):
    inv_freq = ROPE_THETA ** (-jnp.arange(0, MLA_ROPE_DIM, 2, dtype=jnp.float32) / MLA_ROPE_DIM)
    ang = positions.astype(jnp.float32)[..., None] * inv_freq
    return jnp.cos(ang).astype(dtype), jnp.sin(ang).astype(dtype)


def _rope(x, cos, sin):
    x2 = x.reshape(*x.shape[:-1], MLA_ROPE_DIM // 2, 2)
    x0, x1 = x2[..., 0], x2[..., 1]
    out = jnp.stack([x0 * cos - x1 * sin, x0 * sin + x1 * cos], axis=-1)
    return out.reshape(x.shape)


def _mla(h, positions, w_down, q_norm, w_uq, kv_norm, w_uk, w_uv, w_o):
    B, S, _ = h.shape
    H = MLA_HEADS
    lat = h @ w_down
    q_lat, kv_lat, k_pe = jnp.split(lat, [MLA_Q_LORA, MLA_Q_LORA + MLA_KV_LORA], axis=-1)
    q = (_rms_norm(q_lat, q_norm) @ w_uq).reshape(B, S, H, MLA_NOPE_DIM + MLA_ROPE_DIM)
    q_nope, q_pe = q[..., :MLA_NOPE_DIM], q[..., MLA_NOPE_DIM:]
    cos, sin = _rope_cos_sin(positions, h.dtype)
    q_pe = _rope(q_pe, cos[:, :, None, :], sin[:, :, None, :])
    k_pe = _rope(k_pe, cos, sin)
    c_kv = _rms_norm(kv_lat, kv_norm)
    k_nope = (c_kv @ w_uk).reshape(B, S, H, MLA_NOPE_DIM)
    v = (c_kv @ w_uv).reshape(B, S, H, MLA_V_DIM)
    scale = (MLA_NOPE_DIM + MLA_ROPE_DIM) ** -0.5
    chunk_id = jnp.arange(S) // CHUNK
    outs = []
    for qs in range(0, S, Q_BLOCK):
        ke = qs + Q_BLOCK
        s = (jnp.einsum('bqhd,bkhd->bhqk', q_nope[:, qs:ke], k_nope[:, :ke])
             + jnp.einsum('bqhr,bkr->bhqk', q_pe[:, qs:ke], k_pe[:, :ke])).astype(jnp.float32) * scale
        mask = chunk_id[qs:ke, None] >= chunk_id[None, :ke]
        p = jax.nn.softmax(jnp.where(mask, s, -jnp.inf), axis=-1).astype(v.dtype)
        outs.append(jnp.einsum('bhqk,bkhd->bqhd', p, v[:, :ke]))
    o = jnp.concatenate(outs, axis=1).reshape(B, S, H * MLA_V_DIM)
    return o @ w_o


def _fox(h, w_in, b_f, w_o):
    B, S, D = h.shape
    H, Dh = FOX_HEADS, FOX_HEAD_DIM
    proj = h @ w_in
    q, k, v, f_logit = jnp.split(proj, [D, 2 * D, 3 * D], axis=-1)
    q = q.reshape(B, S, H, Dh)
    k = k.reshape(B, S, H, Dh)
    v = v.reshape(B, S, H, Dh)
    log_f = jax.nn.log_sigmoid((f_logit + b_f).astype(jnp.float32))
    cum = jnp.transpose(lax.cumsum(log_f, axis=1), (0, 2, 1))
    scale = Dh ** -0.5
    pos = jnp.arange(S)
    outs = []
    for qs in range(0, S, Q_BLOCK):
        ke = qs + Q_BLOCK
        s = jnp.einsum('bqhd,bkhd->bhqk', q[:, qs:ke], k[:, :ke]).astype(jnp.float32) * scale
        s = s + cum[:, :, qs:ke, None] - cum[:, :, None, :ke]
        mask = pos[qs:ke, None] >= pos[None, :ke]
        p = jax.nn.softmax(jnp.where(mask, s, -jnp.inf), axis=-1).astype(v.dtype)
        outs.append(jnp.einsum('bhqk,bkhd->bqhd', p, v[:, :ke]))
    o = jnp.concatenate(outs, axis=1).reshape(B, S, D)
    return o @ w_o


def _swiglu(h, w1, w3, w2):
    return (jax.nn.silu(h @ w1) * (h @ w3)) @ w2


def _dense(key, shape, fan_in, scale=1.0):
    return jax.random.normal(key, shape, jnp.float32) * (scale * fan_in ** -0.5)


def setup_inputs(seed: int = 0) -> dict:
    key = jax.random.key(seed)
    ks = jax.random.split(key, 32)
    D, L, NA, NB = D_MODEL, DEPTH, N_MLA_LAYERS, N_FOX_LAYERS
    HA, HB = MLA_HEADS, FOX_HEADS
    x = jax.random.normal(ks[0], (BATCH, SEQ, D), jnp.float32)
    c = jax.random.normal(ks[1], (BATCH, D), jnp.float32)
    offset = jax.random.randint(ks[2], (BATCH, 1), 0, 16, dtype=jnp.int32) * CHUNK
    positions = offset + jnp.arange(SEQ, dtype=jnp.int32)[None, :]

    ada_w = _dense(ks[3], (L, D, 6 * D), D, 0.5)
    ada_b = 0.01 * jax.random.normal(ks[4], (L, 6 * D), jnp.float32)
    ln1_g = 1.0 + 0.02 * jax.random.normal(ks[5], (L, D), jnp.float32)
    ln1_b = 0.02 * jax.random.normal(ks[6], (L, D), jnp.float32)
    ln2_g = 1.0 + 0.02 * jax.random.normal(ks[7], (L, D), jnp.float32)
    ln2_b = 0.02 * jax.random.normal(ks[8], (L, D), jnp.float32)
    ffn_w1 = _dense(ks[9], (L, D, D_FF), D)
    ffn_w3 = _dense(ks[10], (L, D, D_FF), D)
    ffn_w2 = _dense(ks[11], (L, D_FF, D), D_FF, DEEPNORM_BETA)

    mla_w_down = _dense(ks[12], (NA, D, MLA_Q_LORA + MLA_KV_LORA + MLA_ROPE_DIM), D)
    mla_q_norm = 1.0 + 0.02 * jax.random.normal(ks[13], (NA, MLA_Q_LORA), jnp.float32)
    mla_w_uq = _dense(ks[14], (NA, MLA_Q_LORA, HA * (MLA_NOPE_DIM + MLA_ROPE_DIM)), MLA_Q_LORA)
    mla_kv_norm = 1.0 + 0.02 * jax.random.normal(ks[15], (NA, MLA_KV_LORA), jnp.float32)
    mla_w_uk = _dense(ks[16], (NA, MLA_KV_LORA, HA * MLA_NOPE_DIM), MLA_KV_LORA)
    mla_w_uv = _dense(ks[17], (NA, MLA_KV_LORA, HA * MLA_V_DIM), MLA_KV_LORA, DEEPNORM_BETA)
    mla_w_o = _dense(ks[18], (NA, HA * MLA_V_DIM, D), HA * MLA_V_DIM, DEEPNORM_BETA)

    fox_wq = _dense(ks[19], (NB, D, D), D)
    fox_wk = _dense(ks[20], (NB, D, D), D)
    fox_wv = _dense(ks[21], (NB, D, D), D, DEEPNORM_BETA)
    fox_wf = _dense(ks[22], (NB, D, HB), D)
    fox_w_in = jnp.concatenate([fox_wq, fox_wk, fox_wv, fox_wf], axis=-1)
    fox_b_f = jax.random.uniform(ks[23], (NB, HB), jnp.float32, 1.0, 4.0)
    fox_w_o = _dense(ks[24], (NB, D, D), D, DEEPNORM_BETA)

    return {
        "x": x, "c": c, "positions": positions,
        "ada_w": ada_w, "ada_b": ada_b,
        "ln1_g": ln1_g, "ln1_b": ln1_b, "ln2_g": ln2_g, "ln2_b": ln2_b,
        "ffn_w1": ffn_w1, "ffn_w3": ffn_w3, "ffn_w2": ffn_w2,
        "mla_w_down": mla_w_down, "mla_q_norm": mla_q_norm, "mla_w_uq": mla_w_uq,
        "mla_kv_norm": mla_kv_norm, "mla_w_uk": mla_w_uk, "mla_w_uv": mla_w_uv, "mla_w_o": mla_w_o,
        "fox_w_in": fox_w_in, "fox_b_f": fox_b_f, "fox_w_o": fox_w_o,
    }


def reference(x, c, positions, ada_w, ada_b, ln1_g, ln1_b, ln2_g, ln2_b,
              ffn_w1, ffn_w3, ffn_w2,
              mla_w_down, mla_q_norm, mla_w_uq, mla_kv_norm, mla_w_uk, mla_w_uv, mla_w_o,
              fox_w_in, fox_b_f, fox_w_o):
    c_act = jax.nn.silu(c)
    for i in range(DEPTH):
        mod = c_act @ ada_w[i] + ada_b[i]
        sh_a, sc_a, g_a, sh_f, sc_f, g_f = [m[:, None, :] for m in jnp.split(mod, 6, axis=-1)]

        h = x * (1.0 + sc_a) + sh_a
        j = i // N_MIXERS
        if i % N_MIXERS == 0:
            y = _mla(h, positions, mla_w_down[j], mla_q_norm[j], mla_w_uq[j],
                     mla_kv_norm[j], mla_w_uk[j], mla_w_uv[j], mla_w_o[j])
        else:
            y = _fox(h, fox_w_in[j], fox_b_f[j], fox_w_o[j])
        x = _layer_norm(DEEPNORM_ALPHA * x + (1.0 + g_a) * y, ln1_g[i], ln1_b[i])

        h = x * (1.0 + sc_f) + sh_f
        y = _swiglu(h, ffn_w1[i], ffn_w3[i], ffn_w2[i])
        x = _layer_norm(DEEPNORM_ALPHA * x + (1.0 + g_f) * y, ln2_g[i], ln2_b[i])
    return x
```

```cpp
#include <hip/hip_runtime.h>
#include <cstdio>
#include <cstdint>

#ifndef PROBE_DUP
#define PROBE_DUP 0
#endif
#ifndef MK_PER_PHASE
#define MK_PER_PHASE 0
#endif

#define LAS __attribute__((address_space(3)))
#define GAS __attribute__((address_space(1)))
typedef _Float16 h16;
typedef _Float16 f16x8 __attribute__((ext_vector_type(8)));
typedef _Float16 f16x2 __attribute__((ext_vector_type(2)));
typedef short s16x4 __attribute__((ext_vector_type(4)));
typedef float f32x2 __attribute__((ext_vector_type(2)));
typedef float f32x4 __attribute__((ext_vector_type(4)));
typedef float f32x16 __attribute__((ext_vector_type(16)));
typedef unsigned u32x2 __attribute__((ext_vector_type(2)));
typedef unsigned u32x4 __attribute__((ext_vector_type(4)));

constexpr int BATCH = 4, SEQ = 2048, M = BATCH * SEQ, D = 2048, NLAYER = 4, FF = 5632;
constexpr int NHEAD = 16, QL = 512, KVL = 512, ROPE_D = 64, NOPE = 128, VD = 128, QKD = NOPE + ROPE_D;
constexpr int LATN = QL + KVL + ROPE_D, LATP = 1280;
constexpr int QN = NHEAD * QKD, KVN = 2 * NHEAD * NOPE, UPN = QN + KVN;
constexpr int PROJN = 3 * D + NHEAD, PROJNP = 6400, PROJP = 3 * D;
constexpr int MODW = 6 * D;
constexpr float DN_ALPHA = 1.6817928305074290f;
constexpr float LN_EPS = 1e-5f, RMS_EPS = 1e-6f;
constexpr float LOG2E = 1.4426950408889634f;

constexpr size_t MiB = 1u << 20;
constexpr size_t WS_CTL = 0, CTL_ZERO_BYTES = 1 * MiB;
constexpr size_t WS_MOD = 1 * MiB;
constexpr size_t WS_SSP = 2 * MiB;
constexpr size_t WS_LOGF = 3 * MiB;
constexpr size_t WS_BIAS = 4 * MiB;
constexpr size_t WS_ROPE = 5 * MiB;
constexpr size_t WS_STATS = 7 * MiB;
constexpr size_t WS_MODP = 8 * MiB;
constexpr size_t WS_X = 24 * MiB;
constexpr size_t WS_H = 88 * MiB;
constexpr size_t WS_LAT = 120 * MiB;
constexpr size_t WS_O = 140 * MiB;
constexpr size_t WS_QKV = 172 * MiB;
constexpr size_t WS_KVOFF = (size_t)M * QN * 2;
constexpr size_t WS_HH = 284 * MiB;
constexpr size_t WS_W = 372 * MiB;
constexpr size_t W_DOWN_SZ = (size_t)LATP * D, W_UP_SZ = (size_t)UPN * QL, W_O_SZ = (size_t)D * D, W_IN_SZ = (size_t)PROJNP * D, W_13_SZ = (size_t)2 * FF * D, W_2_SZ = (size_t)D * FF;
constexpr size_t W_MLA_SZ = W_DOWN_SZ + W_UP_SZ + W_O_SZ, W_FOX_SZ = W_IN_SZ + W_O_SZ, W_FFN_SZ = W_13_SZ + W_2_SZ;
constexpr size_t W_MLA0 = 0, W_FOX0 = 2 * W_MLA_SZ, W_FFN0 = W_FOX0 + 2 * W_FOX_SZ, W_TOTAL = W_FFN0 + 4 * W_FFN_SZ;
constexpr size_t WS_WEND = WS_W + W_TOTAL * 2;
#if PROBE_DUP
constexpr size_t WS_DUMX = (WS_WEND + MiB - 1) / MiB * MiB, WS_DUMH = WS_DUMX + 64 * MiB, WS_END = WS_DUMH + 32 * MiB;
#else
constexpr size_t WS_DUMX = WS_X, WS_DUMH = WS_H, WS_END = WS_WEND;
#endif

constexpr int CW_BAR = 4096;

constexpr int RING_BYTES = 139264;
constexpr int LDSCTL_OFF = RING_BYTES, MISC_OFF = LDSCTL_OFF + 320;
constexpr int LDS_BYTES = 147456;
constexpr int NWAVES = 8;

#define LDS_WAIT() asm volatile("s_waitcnt lgkmcnt(0)" ::: "memory")
#define VM_WAIT() asm volatile("s_waitcnt vmcnt(0)" ::: "memory")

__device__ __forceinline__ int opq_v(int v) { asm volatile("" : "+v"(v)); return v; }
__device__ __forceinline__ int opq_s(int v) { asm volatile("" : "+s"(v)); return v; }
__device__ __forceinline__ unsigned pkh(float lo, float hi) { f16x2 v = {(h16)lo, (h16)hi}; return __builtin_bit_cast(unsigned, v); }
__device__ __forceinline__ u32x4 pk8(f32x4 a, f32x4 b) { u32x4 w; w.x = pkh(a[0], a[1]); w.y = pkh(a[2], a[3]); w.z = pkh(b[0], b[1]); w.w = pkh(b[2], b[3]); return w; }

namespace pg8 {
constexpr int BM = 256, BK = 64, HALF = 128, HTB = HALF * BK * 2, STAGE_BYTES = 8 * HTB, NXCD = 8, WGM = 8;
__host__ __device__ __forceinline__ int lds_byte(int r, int c) { const int st = (r >> 4) * 2 + (c >> 5), rr = r & 15, cc = c & 31, ob = rr * 64 + cc * 2; return st * 1024 + (ob ^ (((ob >> 9) & 1) << 5)); }
__host__ __device__ __forceinline__ void stage_rc(int b, int& R, int& C) { const int st = b / 1024, sb = b % 1024, swz = sb ^ (((sb >> 9) & 1) << 5); R = (st >> 1) * 16 + swz / 64; C = (st & 1) * 32 + (swz % 64) / 2; }
__host__ __device__ __forceinline__ int perm32(int rho) { const int n = rho >> 4, i = rho & 15; return 8 * (i >> 2) + 4 * n + (i & 3); }

struct Unit { int pm, pn; };
struct Gemm { const h16* A; const h16* Bt; int M, N, K, lda; int split_pn, split_off; };

struct StaticOrder {
    int nM, nN, nwg, G, c;
    __device__ void init(int M_, int N_, int G_, int c_) { nM = M_ / BM; nN = N_ / BM; nwg = nM * nN; G = G_; c = c_; }
    __device__ bool next(int i, Unit& u) const {
        const long L = (long)i * G + c; if (L >= nwg) return false;
        int wgid = (int)L; { const int q = nwg / NXCD, r = nwg % NXCD, xcd = wgid % NXCD, off = wgid / NXCD; wgid = (xcd < r ? xcd * (q + 1) : r * (q + 1) + (xcd - r) * q) + off; }
        const int nig = WGM * nN, gid = wgid / nig, fm = gid * WGM, gsz = (nM - fm) < WGM ? (nM - fm) : WGM;
        u.pm = fm + ((wgid % nig) % gsz); u.pn = (wgid % nig) / gsz; return true;
    }
};

typedef f32x4 Acc[2][2][4][2];

template <class Epi, class Sched, bool ALIGN_EPI, bool SP2>
__device__ __forceinline__ void gemm_phase(LAS unsigned char* lds, const Gemm g, const Sched& S, const Epi& E) {
    const int tid = opq_v((int)threadIdx.x), wid = __builtin_amdgcn_readfirstlane(tid >> 6), lane = tid & 63, wr = wid >> 2, wc = wid & 3, fr = lane & 15, fq = lane >> 4;
    const int K = g.K, nt = K / BK, lda = g.lda;
    unsigned voffA[2], voffB[2];
#pragma unroll
    for (int i = 0; i < 2; ++i) { int R, C; stage_rc(tid * 16 + i * 8192, R, C); const int Rb = Epi::PERM ? ((R & ~31) + perm32(R & 31)) : R;
        voffA[i] = (unsigned)(R * lda + C) * 2u; voffB[i] = (unsigned)(Rb * K + C) * 2u; }
    const size_t kstep = (size_t)(BK * 2);
    const size_t hstepA = (size_t)HALF * lda * 2, hstepB = (size_t)HALF * K * 2;
    const size_t tstepA = 2 * hstepA, tstepB = 2 * hstepB;
    const unsigned ldsw = (unsigned)wid * 1024u;
    const int aoff = lds_byte(wr * 64 + fr, fq * 8), boff = lds_byte(wc * 32 + fr, fq * 8);
#define PG8_SA(b, h) (((b) * 2 + (h)) * HTB)
#define PG8_SB(b, h) ((4 + (b) * 2 + (h)) * HTB)
#define PG8_STAGE(bufoff, gbase, voff) do { _Pragma("unroll") for (int _i = 0; _i < 2; ++_i) \
        __builtin_amdgcn_global_load_lds((const unsigned*)((const char*)(gbase) + (voff)[_i]), (LAS unsigned*)(lds + (bufoff) + ldsw + _i * 8192), 16, 0, 0); } while (0)
#define PG8_LDA(dst, b, h) do { _Pragma("unroll") for (int m = 0; m < 4; ++m) _Pragma("unroll") for (int k = 0; k < 2; ++k) dst[m][k] = *(const LAS f16x8*)(lds + PG8_SA(b, h) + aoff + m * 2048 + k * 1024); } while (0)
#define PG8_LDB(dst, b, h) do { _Pragma("unroll") for (int n = 0; n < 2; ++n) _Pragma("unroll") for (int k = 0; k < 2; ++k) dst[n][k] = *(const LAS f16x8*)(lds + PG8_SB(b, h) + boff + n * 2048 + k * 1024); } while (0)
#define PG8_MMA(ai, bj, At, Bt) do { __builtin_amdgcn_s_setprio(1); _Pragma("unroll") for (int m = 0; m < 4; ++m) _Pragma("unroll") for (int n = 0; n < 2; ++n) _Pragma("unroll") for (int k = 0; k < 2; ++k) \
        acc[ai][bj][m][n] = __builtin_amdgcn_mfma_f32_16x16x32_f16(Bt[n][k], At[m][k], acc[ai][bj][m][n], 0, 0, 0); __builtin_amdgcn_s_setprio(0); } while (0)
#define PG8_WAIT_V(n) asm volatile("s_waitcnt vmcnt(" #n ")" ::: "memory")
#define PG8_WAIT_L(n) asm volatile("s_waitcnt lgkmcnt(" #n ")" ::: "memory")
#define PG8_BAR __builtin_amdgcn_s_barrier()
#define PG8_SCHED __builtin_amdgcn_sched_barrier(0)
#define PG8_AOFF(u) ((size_t)(u).pm * tstepA + ((u).pn >= g.split_pn ? (size_t)g.split_off * 2 : (size_t)0))
    Unit cur, nxt; int ui = 0;
    if (!S.next(0, cur)) return;
    Acc acc;
#pragma unroll
    for (int a = 0; a < 2; ++a)
#pragma unroll
        for (int b = 0; b < 2; ++b)
#pragma unroll
            for (int m = 0; m < 4; ++m)
#pragma unroll
                for (int n = 0; n < 2; ++n) acc[a][b][m][n] = (f32x4){0.f, 0.f, 0.f, 0.f};
    f16x8 At[4][2], B0[2][2], B1[2][2];
    const char* cA = (const char*)g.A + PG8_AOFF(cur); const char* cB = (const char*)g.Bt + (size_t)cur.pn * tstepB;
    if constexpr (SP2) {
        PG8_STAGE(PG8_SB(0, 0), cB, voffB); PG8_STAGE(PG8_SB(0, 1), cB + hstepB, voffB); PG8_STAGE(PG8_SA(0, 0), cA, voffA); PG8_STAGE(PG8_SA(0, 1), cA + hstepA, voffA);
        if (wr == 1) PG8_BAR;
        PG8_WAIT_V(2); PG8_BAR;
        PG8_STAGE(PG8_SB(1, 0), cB + kstep, voffB); PG8_STAGE(PG8_SA(1, 0), cA + kstep, voffA); PG8_STAGE(PG8_SB(1, 1), cB + hstepB + kstep, voffB);
        PG8_WAIT_V(6); PG8_BAR;
    } else {
        PG8_STAGE(PG8_SB(0, 0), cB, voffB); PG8_STAGE(PG8_SA(0, 0), cA, voffA); PG8_STAGE(PG8_SB(0, 1), cB + hstepB, voffB); PG8_STAGE(PG8_SA(0, 1), cA + hstepA, voffA);
        if (wr == 1) PG8_BAR;
        PG8_WAIT_V(4); PG8_BAR;
        PG8_STAGE(PG8_SB(1, 0), cB + kstep, voffB); PG8_STAGE(PG8_SA(1, 0), cA + kstep, voffA); PG8_STAGE(PG8_SB(1, 1), cB + hstepB + kstep, voffB);
        PG8_WAIT_V(6); PG8_BAR;
    }
    for (;;) {
        const bool has_next = S.next(ui + 1, nxt);
        const char* nA = has_next ? (const char*)g.A + PG8_AOFF(nxt) : cA; const char* nB = has_next ? (const char*)g.Bt + (size_t)nxt.pn * tstepB : cB;
        for (int t = 0; t < nt; t += 2) {
            const bool last = (t == nt - 2);
            const char* a1 = cA + (size_t)(t + 1) * kstep;
            const char* a2 = last ? nA : cA + (size_t)(t + 2) * kstep; const char* b2 = last ? nB : cB + (size_t)(t + 2) * kstep;
            const char* a3 = a2 + kstep; const char* b3 = b2 + kstep;
            if constexpr (SP2) {
            PG8_LDB(B0, 0, 0); PG8_LDB(B1, 0, 1); PG8_SCHED; PG8_LDA(At, 0, 0); PG8_STAGE(PG8_SA(1, 1), a1 + hstepA, voffA);
            PG8_WAIT_V(8); PG8_WAIT_L(0); PG8_BAR; PG8_MMA(0, 0, At, B0); PG8_MMA(0, 1, At, B1); PG8_BAR; PG8_SCHED;
            PG8_LDA(At, 0, 1); PG8_STAGE(PG8_SB(0, 0), b2, voffB); PG8_STAGE(PG8_SB(0, 1), b2 + hstepB, voffB); PG8_STAGE(PG8_SA(0, 0), a2, voffA);
            PG8_WAIT_V(8); PG8_WAIT_L(0); PG8_BAR; PG8_MMA(1, 0, At, B0); PG8_MMA(1, 1, At, B1); PG8_BAR; PG8_SCHED;
            PG8_LDB(B0, 1, 0); PG8_LDB(B1, 1, 1); PG8_SCHED; PG8_LDA(At, 1, 0); PG8_STAGE(PG8_SA(0, 1), a2 + hstepA, voffA);
            PG8_WAIT_V(8); PG8_WAIT_L(0); PG8_BAR; PG8_MMA(0, 0, At, B0); PG8_MMA(0, 1, At, B1); PG8_BAR; PG8_SCHED;
            PG8_LDA(At, 1, 1); PG8_STAGE(PG8_SB(1, 0), b3, voffB); PG8_STAGE(PG8_SB(1, 1), b3 + hstepB, voffB); PG8_STAGE(PG8_SA(1, 0), a3, voffA);
            PG8_WAIT_V(8); PG8_WAIT_L(0); PG8_BAR; PG8_MMA(1, 0, At, B0); PG8_MMA(1, 1, At, B1); PG8_BAR; PG8_SCHED;
            } else {
            PG8_LDB(B0, 0, 0); PG8_SCHED; PG8_LDA(At, 0, 0); PG8_STAGE(PG8_SA(1, 1), a1 + hstepA, voffA);
            PG8_WAIT_L(8); PG8_BAR; PG8_WAIT_L(0); PG8_MMA(0, 0, At, B0); PG8_BAR; PG8_SCHED;
            PG8_LDB(B1, 0, 1); PG8_STAGE(PG8_SB(0, 0), b2, voffB);
            PG8_BAR; PG8_WAIT_L(0); PG8_MMA(0, 1, At, B1); PG8_BAR;
            PG8_LDA(At, 0, 1); PG8_STAGE(PG8_SA(0, 0), a2, voffA);
            PG8_BAR; PG8_WAIT_L(0); PG8_MMA(1, 0, At, B0); PG8_BAR; PG8_SCHED;
            PG8_STAGE(PG8_SB(0, 1), b2 + hstepB, voffB);
            PG8_WAIT_V(6); PG8_BAR; PG8_MMA(1, 1, At, B1); PG8_BAR;
            PG8_LDB(B0, 1, 0); PG8_SCHED; PG8_LDA(At, 1, 0); PG8_STAGE(PG8_SA(0, 1), a2 + hstepA, voffA);
            PG8_WAIT_L(8); PG8_BAR; PG8_WAIT_L(0); PG8_MMA(0, 0, At, B0); PG8_BAR; PG8_SCHED;
            PG8_LDB(B1, 1, 1); PG8_STAGE(PG8_SB(1, 0), b3, voffB);
            PG8_BAR; PG8_WAIT_L(0); PG8_MMA(0, 1, At, B1); PG8_BAR;
            PG8_LDA(At, 1, 1); PG8_STAGE(PG8_SA(1, 0), a3, voffA);
            PG8_BAR; PG8_WAIT_L(0); PG8_MMA(1, 0, At, B0); PG8_BAR; PG8_SCHED;
            PG8_STAGE(PG8_SB(1, 1), b3 + hstepB, voffB);
            PG8_WAIT_V(6); PG8_BAR; PG8_MMA(1, 1, At, B1); PG8_BAR;
            }
        }
        if constexpr (ALIGN_EPI) { if (wr == 0) PG8_BAR; }
        E(acc, cur, wr, wc, fr, fq);
        if (!has_next) break;
#pragma unroll
        for (int a = 0; a < 2; ++a)
#pragma unroll
            for (int b = 0; b < 2; ++b)
#pragma unroll
                for (int m = 0; m < 4; ++m)
#pragma unroll
                    for (int n = 0; n < 2; ++n) acc[a][b][m][n] = (f32x4){0.f, 0.f, 0.f, 0.f};
        cur = nxt; cA = nA; cB = nB; ++ui;
        if constexpr (ALIGN_EPI) { if (wr == 1) PG8_BAR; }
    }
    PG8_WAIT_V(0);
    if constexpr (!ALIGN_EPI) { if (wr == 0) PG8_BAR; }
    PG8_BAR;
#undef PG8_SA
#undef PG8_SB
#undef PG8_STAGE
#undef PG8_LDA
#undef PG8_LDB
#undef PG8_MMA
#undef PG8_WAIT_V
#undef PG8_WAIT_L
#undef PG8_BAR
#undef PG8_SCHED
#undef PG8_AOFF
}

__device__ __forceinline__ void rope4(f32x4& v0, f32x4& v1, const float* cs) {
    const f32x4 a = *(const f32x4*)cs, b = *(const f32x4*)(cs + 4);
    f32x4 o0, o1;
    o0[0] = v0[0] * a[0] - v0[1] * a[1]; o0[1] = v0[0] * a[1] + v0[1] * a[0];
    o0[2] = v0[2] * a[2] - v0[3] * a[3]; o0[3] = v0[2] * a[3] + v0[3] * a[2];
    o1[0] = v1[0] * b[0] - v1[1] * b[1]; o1[1] = v1[0] * b[1] + v1[1] * b[0];
    o1[2] = v1[2] * b[2] - v1[3] * b[3]; o1[3] = v1[2] * b[3] + v1[3] * b[2];
    v0 = o0; v1 = o1;
}
struct EpiDown {
    static constexpr bool PERM = true;
    h16* LAT; float* SSP; const float* ROPE;
    __device__ __forceinline__ void operator()(const Acc& acc, const Unit& u, int wr, int wc, int fr, int fq) const {
        const int col0 = u.pn * BM + wc * 32 + 8 * fq;
#pragma unroll
        for (int ai = 0; ai < 2; ++ai)
#pragma unroll
            for (int m = 0; m < 4; ++m) {
                const int row = u.pm * BM + ai * HALF + wr * 64 + m * 16 + fr; float ss = 0.f;
#pragma unroll
                for (int bj = 0; bj < 2; ++bj) { f32x4 v0 = acc[ai][bj][m][0], v1 = acc[ai][bj][m][1];
                    ss += (v0[0] * v0[0] + v0[1] * v0[1]) + (v0[2] * v0[2] + v0[3] * v0[3]) + (v1[0] * v1[0] + v1[1] * v1[1]) + (v1[2] * v1[2] + v1[3] * v1[3]);
                    if (u.pn == 4 && bj == 0 && wc < 2) rope4(v0, v1, ROPE + ((size_t)row * 32 + 16 * wc + 4 * fq) * 2);
                    *(u32x4*)(LAT + (size_t)row * LATP + col0 + bj * HALF) = pk8(v0, v1); }
                if (u.pn < 4) { ss += __shfl_xor(ss, 16); ss += __shfl_xor(ss, 32); if (fq == 0) SSP[(size_t)row * 16 + u.pn * 4 + wc] = ss; }
            }
    }
};
struct EpiUp {
    static constexpr bool PERM = true;
    h16* Q; h16* KV; const float* SSP; const float* ROPE;
    __device__ __forceinline__ void operator()(const Acc& acc, const Unit& u, int wr, int wc, int fr, int fq) const {
        const bool isq = u.pn < 12;
        const int colt = (isq ? u.pn : u.pn - 12) * BM + wc * 32 + 8 * fq;
#pragma unroll
        for (int ai = 0; ai < 2; ++ai)
#pragma unroll
            for (int m = 0; m < 4; ++m) {
                const int row = u.pm * BM + ai * HALF + wr * 64 + m * 16 + fr;
                const f32x4* sp = (const f32x4*)(SSP + (size_t)row * 16 + (isq ? 0 : 8)); const f32x4 s0 = sp[0], s1 = sp[1];
                const float ss = ((s0[0] + s0[1]) + (s0[2] + s0[3])) + ((s1[0] + s1[1]) + (s1[2] + s1[3]));
                const float rstd = 1.0f / sqrtf(ss * (1.0f / 512.0f) + RMS_EPS);
#pragma unroll
                for (int bj = 0; bj < 2; ++bj) { f32x4 v0 = acc[ai][bj][m][0] * rstd, v1 = acc[ai][bj][m][1] * rstd; const int col = colt + bj * HALF;
                    if (isq) { const int within = col % QKD;
                        if (within >= NOPE) rope4(v0, v1, ROPE + ((size_t)row * 32 + ((within - NOPE) >> 1)) * 2);
                        *(u32x4*)(Q + (size_t)row * QN + col) = pk8(v0, v1); }
                    else *(u32x4*)(KV + (size_t)row * KVN + col) = pk8(v0, v1); }
            }
    }
};
struct EpiProj {
    static constexpr bool PERM = true;
    h16* P;
    __device__ __forceinline__ void operator()(const Acc& acc, const Unit& u, int wr, int wc, int fr, int fq) const {
        const int col0 = u.pn * BM + wc * 32 + 8 * fq;
#pragma unroll
        for (int ai = 0; ai < 2; ++ai)
#pragma unroll
            for (int m = 0; m < 4; ++m) { const int row = u.pm * BM + ai * HALF + wr * 64 + m * 16 + fr;
#pragma unroll
                for (int bj = 0; bj < 2; ++bj) *(u32x4*)(P + (size_t)row * PROJP + col0 + bj * HALF) = pk8(acc[ai][bj][m][0], acc[ai][bj][m][1]); }
    }
};
struct EpiSwiglu {
    static constexpr bool PERM = true;
    h16* HH;
    __device__ __forceinline__ void operator()(const Acc& acc, const Unit& u, int wr, int wc, int fr, int fq) const {
        const int col0 = u.pn * HALF + wc * 32 + 8 * fq;
#pragma unroll
        for (int ai = 0; ai < 2; ++ai)
#pragma unroll
            for (int m = 0; m < 4; ++m) { const int row = u.pm * BM + ai * HALF + wr * 64 + m * 16 + fr; f32x4 h0, h1;
#pragma unroll
                for (int e = 0; e < 4; ++e) { const float g0 = acc[ai][0][m][0][e], g1 = acc[ai][0][m][1][e];
                    h0[e] = g0 * __builtin_amdgcn_rcpf(1.0f + __expf(-g0)) * acc[ai][1][m][0][e]; h1[e] = g1 * __builtin_amdgcn_rcpf(1.0f + __expf(-g1)) * acc[ai][1][m][1][e]; }
                *(u32x4*)(HH + (size_t)row * FF + col0) = pk8(h0, h1); }
    }
};
struct EpiRes {
    static constexpr bool PERM = true;
    const float* xin32; const h16* xin16; h16* X; const float* gate; const float* st; const float* lg; const float* lb;
    __device__ __forceinline__ void operator()(const Acc& acc, const Unit& u, int wr, int wc, int fr, int fq) const {
        const int col0 = u.pn * BM + wc * 32 + 8 * fq; const float* gp = gate + (size_t)(u.pm >> 3) * MODW + col0;
        f32x4 gv[2][2], lgv[2][2], lbv[2][2];
#pragma unroll
        for (int bj = 0; bj < 2; ++bj)
#pragma unroll
            for (int n = 0; n < 2; ++n) { gv[bj][n] = *(const f32x4*)(gp + bj * HALF + 4 * n) + 1.0f;
                if (!xin32) { lgv[bj][n] = *(const f32x4*)(lg + col0 + bj * HALF + 4 * n) * DN_ALPHA; lbv[bj][n] = *(const f32x4*)(lb + col0 + bj * HALF + 4 * n) * DN_ALPHA; } }
#pragma unroll
        for (int ai = 0; ai < 2; ++ai)
#pragma unroll
            for (int m = 0; m < 4; ++m) { const int row = u.pm * BM + ai * HALF + wr * 64 + m * 16 + fr; const size_t off = (size_t)row * D + col0;
                f32x2 ms = {0.f, 0.f}; if (!xin32) ms = *(const f32x2*)(st + (size_t)row * 2);
#pragma unroll
                for (int bj = 0; bj < 2; ++bj) { f32x4 xa0, xa1;
                    if (xin32) { xa0 = *(const f32x4*)(xin32 + off + bj * HALF) * DN_ALPHA; xa1 = *(const f32x4*)(xin32 + off + bj * HALF + 4) * DN_ALPHA; }
                    else { const f16x8 xv = *(const f16x8*)(xin16 + off + bj * HALF);
                        f32x4 x0 = {(float)xv[0], (float)xv[1], (float)xv[2], (float)xv[3]}, x1 = {(float)xv[4], (float)xv[5], (float)xv[6], (float)xv[7]};
                        xa0 = (x0 - ms[0]) * ms[1] * lgv[bj][0] + lbv[bj][0]; xa1 = (x1 - ms[0]) * ms[1] * lgv[bj][1] + lbv[bj][1]; }
                    *(u32x4*)(X + off + bj * HALF) = pk8(xa0 + gv[bj][0] * acc[ai][bj][m][0], xa1 + gv[bj][1] * acc[ai][bj][m][1]); } }
    }
};
}

namespace att {
constexpr int NW = 8, QBLK = 32, KVBLK = 64, QB = NW * QBLK;
constexpr int SHM_V = KVBLK * 128 * 2;
constexpr int SHM_KMAX = KVBLK * 512;
constexpr int OFF_V = 0, OFF_K = 2 * SHM_V, OFF_WS = OFF_K + 2 * SHM_KMAX, OFF_BIAS = OFF_WS + NW * 64 * 4, ATT_LDS = OFF_BIAS + 2 * 64 * 4;
static_assert(ATT_LDS <= RING_BYTES, "attention LDS");
constexpr float THR = 8.f;
#define SBAR() __builtin_amdgcn_sched_barrier(0)
typedef LAS char* lptr;
__device__ __forceinline__ int v_st(int k, int c) { const int kk = (k & ~0xC) | ((k & 4) << 1) | ((k & 8) >> 1); return ((kk >> 3) * 4 + (c >> 5)) * 512 + ((kk & 7) * 32 + (c & 31)) * 2; }
__device__ __forceinline__ int v_rd_base(int lane) { return ((lane & 3) << 3) | (((lane >> 2) & 3) << 6) | (((lane >> 4) & 1) << 5) | (((lane >> 5) & 1) << 8); }
constexpr int v_rd_off(int d0, int ks, int half) { return d0 * 512 + ks * 4096 + half * 2048; }
__device__ __forceinline__ int crow(int r, int hi) { return (r & 3) + 8 * (r >> 2) + 4 * hi; }
__device__ __forceinline__ f16x8 ld8(const h16* p) { return *reinterpret_cast<const f16x8*>(p); }

template <int MODE> struct Cfg;
template <> struct Cfg<0> { static constexpr int KROWB = 512, NQF = 12, PQ = QN, PK = KVN, PV = KVN; static constexpr float SCALE = 0.07216878364870322f; };
template <> struct Cfg<1> { static constexpr int KROWB = 256, NQF = 8, PQ = PROJP, PK = PROJP, PV = PROJP; static constexpr float SCALE = 0.08838834764831845f; };

__device__ __forceinline__ void mask_tile(f32x16& p0, f32x16& p1, int dq) {
    const float NEG = -__builtin_inff();
#pragma unroll
    for (int r = 0; r < 16; ++r) { const int c = (r & 3) + 8 * (r >> 2);
        if (dq - c < 0) p0[r] = NEG;
        if (dq - c - 32 < 0) p1[r] = NEG; }
}
template <int MODE>
__device__ __forceinline__ void partialSM(f32x16& p0, f32x16& p1, float& m_reg, float& mn, float& alpha) {
    float pmax = p0[0];
#pragma unroll
    for (int r = 1; r < 16; ++r) pmax = fmaxf(pmax, p0[r]);
#pragma unroll
    for (int r = 0; r < 16; ++r) pmax = fmaxf(pmax, p1[r]);
    { auto rr = __builtin_amdgcn_permlane32_swap(__float_as_uint(pmax), __float_as_uint(pmax), false, false);
      pmax = fmaxf(__uint_as_float(rr[0]), __uint_as_float(rr[1])); }
    if constexpr (MODE == 0) {
        constexpr float SC = Cfg<0>::SCALE, C2 = LOG2E * SC;
        if (__builtin_expect(__all((pmax - m_reg) * SC <= THR), 1)) { mn = m_reg; alpha = 1.f; }
        else { mn = fmaxf(m_reg, pmax); alpha = __builtin_amdgcn_exp2f((m_reg - mn) * C2); m_reg = mn; }
        const float mnL = -mn * C2;
#pragma unroll
        for (int r = 0; r < 16; ++r) p0[r] = fmaf(p0[r], C2, mnL);
#pragma unroll
        for (int r = 0; r < 16; ++r) p1[r] = fmaf(p1[r], C2, mnL);
    } else {
        if (__builtin_expect(__all((pmax - m_reg) <= THR * LOG2E), 1)) { mn = m_reg; alpha = 1.f; }
        else { mn = fmaxf(m_reg, pmax); alpha = __builtin_amdgcn_exp2f(m_reg - mn); m_reg = mn; }
#pragma unroll
        for (int r = 0; r < 16; ++r) p0[r] = p0[r] - mn;
#pragma unroll
        for (int r = 0; r < 16; ++r) p1[r] = p1[r] - mn;
    }
#pragma unroll
    for (int r = 0; r < 16; ++r) p0[r] = __builtin_amdgcn_exp2f(p0[r]);
}
__device__ __forceinline__ void finishSM(f32x16& p0, f32x16& p1, float alpha, float& l_reg, f16x8& pa0, f16x8& pa1, f16x8& pa2, f16x8& pa3) {
#pragma unroll
    for (int r = 0; r < 16; ++r) p1[r] = __builtin_amdgcn_exp2f(p1[r]);
    float ps = 0;
#pragma unroll
    for (int r = 0; r < 16; ++r) ps += p0[r];
#pragma unroll
    for (int r = 0; r < 16; ++r) ps += p1[r];
    { auto rr = __builtin_amdgcn_permlane32_swap(__float_as_uint(ps), __float_as_uint(ps), false, false);
      ps = __uint_as_float(rr[0]) + __uint_as_float(rr[1]); }
    l_reg = l_reg * alpha + ps;
#define PK4(P, B_, OUT) do { unsigned a0 = pkh(P[B_+0], P[B_+1]), a1 = pkh(P[B_+2], P[B_+3]);                          \
        unsigned b0 = pkh(P[B_+4], P[B_+5]), b1 = pkh(P[B_+6], P[B_+7]);                                             \
        auto r0 = __builtin_amdgcn_permlane32_swap(a0, b0, false, false); auto r1 = __builtin_amdgcn_permlane32_swap(a1, b1, false, false); \
        u32x4 w = {r0[0], r1[0], r0[1], r1[1]}; OUT = __builtin_bit_cast(f16x8, w); } while (0)
    PK4(p0, 0, pa0); PK4(p0, 8, pa1); PK4(p1, 0, pa2); PK4(p1, 8, pa3);
#undef PK4
}
template <int MODE, int KB>
__device__ __forceinline__ void qkt(f32x16& p0, f32x16& p1, lptr K_lds, int r32, int hi, const f16x8* qr) {
    constexpr int KROWB = Cfg<MODE>::KROWB, NQF = Cfg<MODE>::NQF;
    p0 = f32x16{}; p1 = f32x16{};
    lptr kb[4];
#pragma unroll
    for (int dd = 0; dd < 4; ++dd) kb[dd] = K_lds + KB * SHM_KMAX + r32 * KROWB + (((dd * 16 + hi * 8) * 2) ^ ((r32 & 7) << 4));
#pragma unroll
    for (int d0 = 0; d0 < NQF; ++d0) { lptr a = kb[d0 & 3] + (d0 >> 2) * 128;
        const f16x8 b0 = *(const LAS f16x8*)(a);
        const f16x8 b1 = *(const LAS f16x8*)(a + 32 * KROWB);
        p0 = __builtin_amdgcn_mfma_f32_32x32x16_f16(b0, qr[d0], p0, 0, 0, 0);
        p1 = __builtin_amdgcn_mfma_f32_32x32x16_f16(b1, qr[d0], p1, 0, 0, 0); }
}
template <int MODE, int KB>
__device__ __forceinline__ void qkt2(f32x16& p0, f32x16& p1, const unsigned (&kbv)[4], const f16x8* qr) {
    constexpr int KROWB = Cfg<MODE>::KROWB, NQF = Cfg<MODE>::NQF, NG = NQF / 2, B0 = KB * SHM_KMAX, H = 32 * KROWB;
#define KRD(dst, d0) do { asm volatile("ds_read_b128 %0, %1 offset:%2" : "=&v"(dst[0]) : "v"(kbv[(d0) & 3]), "i"(B0 + ((d0) >> 2) * 128) : "memory");        \
                          asm volatile("ds_read_b128 %0, %1 offset:%2" : "=&v"(dst[1]) : "v"(kbv[(d0) & 3]), "i"(B0 + ((d0) >> 2) * 128 + H) : "memory"); } while (0)
    f16x8 ka[2][2], kb[2][2];
    p0 = f32x16{}; p1 = f32x16{};
    KRD(ka[0], 0); KRD(ka[1], 1); KRD(kb[0], 2); KRD(kb[1], 3);
#pragma unroll
    for (int g = 0; g < NG; ++g) {
        if (g + 1 < NG) asm volatile("s_waitcnt lgkmcnt(4)" ::: "memory"); else asm volatile("s_waitcnt lgkmcnt(0)" ::: "memory");
        SBAR();
        if ((g & 1) == 0) {
            p0 = __builtin_amdgcn_mfma_f32_32x32x16_f16(ka[0][0], qr[2 * g], p0, 0, 0, 0); p1 = __builtin_amdgcn_mfma_f32_32x32x16_f16(ka[0][1], qr[2 * g], p1, 0, 0, 0);
            p0 = __builtin_amdgcn_mfma_f32_32x32x16_f16(ka[1][0], qr[2 * g + 1], p0, 0, 0, 0); p1 = __builtin_amdgcn_mfma_f32_32x32x16_f16(ka[1][1], qr[2 * g + 1], p1, 0, 0, 0);
            SBAR();
            if (g + 2 < NG) { KRD(ka[0], 2 * g + 4); KRD(ka[1], 2 * g + 5); }
        } else {
            p0 = __builtin_amdgcn_mfma_f32_32x32x16_f16(kb[0][0], qr[2 * g], p0, 0, 0, 0); p1 = __builtin_amdgcn_mfma_f32_32x32x16_f16(kb[0][1], qr[2 * g], p1, 0, 0, 0);
            p0 = __builtin_amdgcn_mfma_f32_32x32x16_f16(kb[1][0], qr[2 * g + 1], p0, 0, 0, 0); p1 = __builtin_amdgcn_mfma_f32_32x32x16_f16(kb[1][1], qr[2 * g + 1], p1, 0, 0, 0);
            SBAR();
            if (g + 2 < NG) { KRD(kb[0], 2 * g + 4); KRD(kb[1], 2 * g + 5); }
        }
    }
#undef KRD
}
template <int VB>
__device__ __forceinline__ void pv_tile(f32x16* o, int vb0, f16x8 pa0, f16x8 pa1, f16x8 pa2, f16x8 pa3) {
#define TRRD(dst, off) asm volatile("ds_read_b64_tr_b16 %0, %1 offset:%2" : "=&v"(dst) : "v"(vb0), "i"(off) : "memory")
#define MK8(l, h) __builtin_bit_cast(f16x8, __builtin_shufflevector(l, h, 0, 1, 2, 3, 4, 5, 6, 7))
#define PV_D0(d0) do { s16x4 l0, l1, l2, l3, h0, h1, h2, h3; constexpr int b_ = VB * SHM_V + v_rd_off(d0, 0, 0);   \
        TRRD(l0, b_); TRRD(h0, b_ + 2048); TRRD(l1, b_ + 4096); TRRD(h1, b_ + 6144); TRRD(l2, b_ + 8192); TRRD(h2, b_ + 10240); TRRD(l3, b_ + 12288); TRRD(h3, b_ + 14336); \
        asm volatile("s_waitcnt lgkmcnt(0)" ::: "memory"); SBAR();                                                   \
        o[d0] = __builtin_amdgcn_mfma_f32_32x32x16_f16(pa0, MK8(l0, h0), o[d0], 0, 0, 0);   \
        o[d0] = __builtin_amdgcn_mfma_f32_32x32x16_f16(pa1, MK8(l1, h1), o[d0], 0, 0, 0);   \
        o[d0] = __builtin_amdgcn_mfma_f32_32x32x16_f16(pa2, MK8(l2, h2), o[d0], 0, 0, 0);   \
        o[d0] = __builtin_amdgcn_mfma_f32_32x32x16_f16(pa3, MK8(l3, h3), o[d0], 0, 0, 0); } while (0)
    PV_D0(0); PV_D0(1); PV_D0(2); PV_D0(3);
#undef PV_D0
#undef MK8
#undef TRRD
}

struct BlockRef { const h16* Q; const h16* K; const h16* V; h16* O; const h16* KP; const float* BI; int P0; };
template <int MODE> struct Seam { f16x8 qr[Cfg<MODE>::NQF]; f16x8 st_v0, st_v1, st_k0, st_k1, st_p; float st_b; };

#define VMW() asm volatile("s_waitcnt vmcnt(0)" ::: "memory")
#define VMWN(n) asm volatile("s_waitcnt vmcnt(%0)" :: "i"(n) : "memory")
#define AT_SLOAD(R, k0) do { S.st_v0 = ld8((R).V + (size_t)((k0) + sr) * PV + sc); S.st_v1 = ld8((R).V + (size_t)((k0) + 32 + sr) * PV + sc);              \
                             S.st_k0 = ld8((R).K + (size_t)((k0) + sr) * PK + sc); S.st_k1 = ld8((R).K + (size_t)((k0) + 32 + sr) * PK + sc);              \
                             if constexpr (MODE == 0) S.st_p = ld8((R).KP + (size_t)((k0) + (tid >> 3)) * LATP + (tid & 7) * 8);                         \
                             else S.st_b = (R).BI[(k0) + lane]; } while (0)
#define AT_SWRITE_K(bf) do { *(LAS f16x8*)(K_lds + (bf) * SHM_KMAX + kws) = S.st_k0; *(LAS f16x8*)(K_lds + (bf) * SHM_KMAX + kws + 32 * KROWB) = S.st_k1;     \
                             if constexpr (MODE == 0) *(LAS f16x8*)(K_lds + (bf) * SHM_KMAX + kwp) = S.st_p;                                                \
                             else { if (wid == 0) bias_l[(bf) * 64 + lane] = S.st_b; } } while (0)
#define AT_SWRITE_V(bf) do { *(LAS f16x8*)(V_lds + (bf) * SHM_V + vst0) = S.st_v0; *(LAS f16x8*)(V_lds + (bf) * SHM_V + vst1) = S.st_v1; } while (0)
#define AT_SWRITE(bf) do { AT_SWRITE_V(bf); AT_SWRITE_K(bf); } while (0)

template <int MODE>
__device__ __forceinline__ void attn_prime(const BlockRef& cur, lptr lds, Seam<MODE>& S) {
    constexpr int KROWB = Cfg<MODE>::KROWB, NQF = Cfg<MODE>::NQF, PQ = Cfg<MODE>::PQ, PK = Cfg<MODE>::PK, PV = Cfg<MODE>::PV;
    const int tid = opq_v((int)threadIdx.x), wid = __builtin_amdgcn_readfirstlane(tid >> 6), lane = tid & 63, r32 = lane & 31, hi = lane >> 5;
    const int sr = tid >> 4, sc = (tid & 15) * 8;
    const int kws = sr * KROWB + ((sc * 2) ^ ((sr & 7) << 4));
    const int kwp = (tid >> 3) * KROWB + ((256 + (tid & 7) * 16) ^ (((tid >> 3) & 7) << 4));
    lptr K_lds = lds + OFF_K; LAS float* bias_l = (LAS float*)(lds + OFF_BIAS);
    (void)kwp; (void)bias_l;
#pragma unroll
    for (int d0 = 0; d0 < NQF; ++d0) S.qr[d0] = ld8(cur.Q + (size_t)(wid * QBLK + r32) * PQ + d0 * 16 + hi * 8);
    AT_SLOAD(cur, 0); VMW(); AT_SWRITE_K(0);
    __syncthreads();
}
template <int MODE>
__device__ __forceinline__ void attn_block(const BlockRef& cur, const BlockRef& nxt, lptr lds, Seam<MODE>& S) {
    constexpr int KROWB = Cfg<MODE>::KROWB, NQF = Cfg<MODE>::NQF, PQ = Cfg<MODE>::PQ, PK = Cfg<MODE>::PK, PV = Cfg<MODE>::PV;
    const int tid = opq_v((int)threadIdx.x), wid = __builtin_amdgcn_readfirstlane(tid >> 6), lane = tid & 63, r32 = lane & 31, hi = lane >> 5;
    const int NT = cur.P0 / KVBLK + QB / KVBLK;
    const int qlo = cur.P0 + wid * QBLK;
    const int qeff = (MODE == 0) ? (qlo | 63) : qlo;
    const int qm = ((MODE == 0) ? (qlo | 63) : (qlo + r32)) - 4 * hi;
    lptr V_lds = lds + OFF_V; lptr K_lds = lds + OFF_K;
    LAS float* ws = (LAS float*)(lds + OFF_WS) + wid * 64; LAS float* li_l = ws; LAS float* al_l = ws + 32;
    LAS float* bias_l = (LAS float*)(lds + OFF_BIAS);
    float m_reg = -1e30f, l_reg = 0; f32x16 o[4] = {};
    const int sr = tid >> 4, sc = (tid & 15) * 8, vst0 = v_st(sr, sc), vst1 = v_st(32 + sr, sc);
    const int kws = sr * KROWB + ((sc * 2) ^ ((sr & 7) << 4));
    const int kwp = (tid >> 3) * KROWB + ((256 + (tid & 7) * 16) ^ (((tid >> 3) & 7) << 4));
    (void)kwp; (void)bias_l;
    const int vb0 = (int)(unsigned)(uintptr_t)V_lds + v_rd_base(lane);
#define RESC(a) do { if (__any((a) < 1.f)) { if (hi == 0) al_l[r32] = (a); asm volatile("s_waitcnt lgkmcnt(0)" ::: "memory");              \
                     _Pragma("unroll") for (int d_ = 0; d_ < 4; ++d_) _Pragma("unroll") for (int r = 0; r < 16; ++r) o[d_][r] *= al_l[crow(r, hi)]; } } while (0)
#define KBASE(t) ((t) * KVBLK)
#define BIASADD(P0_, P1_, KBUF) do { if constexpr (MODE == 1) { constexpr float C2 = LOG2E * Cfg<1>::SCALE; const LAS float* bb = bias_l + (KBUF) * 64 + 4 * hi;   \
        _Pragma("unroll") for (int g_ = 0; g_ < 4; ++g_) { const f32x4 ba = *(const LAS f32x4*)(bb + 8 * g_), bc = *(const LAS f32x4*)(bb + 32 + 8 * g_);          \
            _Pragma("unroll") for (int e_ = 0; e_ < 4; ++e_) { P0_[4 * g_ + e_] = fmaf(P0_[4 * g_ + e_], C2, ba[e_]); P1_[4 * g_ + e_] = fmaf(P1_[4 * g_ + e_], C2, bc[e_]); } } } } while (0)
#define MASKT(P0_, P1_, t) do { const int kb_ = KBASE(t); if (kb_ + KVBLK - 1 > qeff) mask_tile(P0_, P1_, qm - kb_); } while (0)
#define SEAM_K0() do { VMWN(NQF); AT_SWRITE_K(0); SBAR(); } while (0)
    f32x16 pA0, pA1, pB0, pB1; float mnA, mnB, alA, alB; f16x8 pa0, pa1, pa2, pa3;
    AT_SWRITE_V(0); SBAR();
    AT_SLOAD(cur, KBASE(1));
    SBAR(); qkt<MODE, 0>(pA0, pA1, K_lds, r32, hi, S.qr);
    BIASADD(pA0, pA1, 0); MASKT(pA0, pA1, 0); partialSM<MODE>(pA0, pA1, m_reg, mnA, alA);
    VMW(); AT_SWRITE(1);
    __syncthreads();
#define HALF_STEP(PX0, PX1, mnX, alX, PY0, PY1, alY, t, KB, VB, SB) do {                                                      \
        SBAR(); qkt<MODE, KB>(PX0, PX1, K_lds, r32, hi, S.qr);                                                                \
        finishSM(PY0, PY1, alY, l_reg, pa0, pa1, pa2, pa3); SBAR();                                                           \
        if ((t) + 1 < NT) { AT_SLOAD(cur, KBASE((t) + 1)); SBAR(); }                                                          \
        pv_tile<VB>(o, vb0, pa0, pa1, pa2, pa3); BIASADD(PX0, PX1, KB); MASKT(PX0, PX1, (t)); partialSM<MODE>(PX0, PX1, m_reg, mnX, alX);   \
        __syncthreads();                                                                                                      \
        if ((t) + 1 < NT) { VMW(); AT_SWRITE(SB); }                                                                           \
        RESC(alX); __syncthreads(); } while (0)
    for (int t = 1; t + 1 < NT; t += 2) {
        HALF_STEP(pB0, pB1, mnB, alB, pA0, pA1, alA, t, 1, 0, 0);
        HALF_STEP(pA0, pA1, mnA, alA, pB0, pB1, alB, t + 1, 0, 1, 1);
    }
    SBAR(); qkt<MODE, 1>(pB0, pB1, K_lds, r32, hi, S.qr); SBAR();
    AT_SLOAD(nxt, 0); SBAR();
#pragma unroll
    for (int d0 = 0; d0 < NQF; ++d0) S.qr[d0] = ld8(nxt.Q + (size_t)(wid * QBLK + r32) * PQ + d0 * 16 + hi * 8);
    SBAR();
    finishSM(pA0, pA1, alA, l_reg, pa0, pa1, pa2, pa3); SBAR();
    pv_tile<0>(o, vb0, pa0, pa1, pa2, pa3);
    BIASADD(pB0, pB1, 1); MASKT(pB0, pB1, NT - 1); partialSM<MODE>(pB0, pB1, m_reg, mnB, alB); __syncthreads(); RESC(alB);
    finishSM(pB0, pB1, alB, l_reg, pa0, pa1, pa2, pa3); SBAR(); pv_tile<1>(o, vb0, pa0, pa1, pa2, pa3);
    SBAR(); SEAM_K0();
    if (hi == 0) li_l[r32] = l_reg; asm volatile("s_waitcnt lgkmcnt(0)" ::: "memory");
    float rli[16];
#pragma unroll
    for (int r = 0; r < 16; ++r) rli[r] = __builtin_amdgcn_rcpf(li_l[crow(r, hi)]);
    h16* Ow = cur.O + (size_t)(wid * QBLK) * D;
#pragma unroll
    for (int r = 0; r < 16; ++r) { const int orow = crow(r, hi);
#pragma unroll
        for (int d0 = 0; d0 < 4; ++d0) { const float v = o[d0][r] * rli[r];
            const float vn = __shfl_xor(v, 1);
            if ((r32 & 1) == 0) *(unsigned*)(Ow + (size_t)orow * D + d0 * 32 + r32) = pkh(v, vn); } }
    __syncthreads();
#undef RESC
#undef KBASE
#undef BIASADD
#undef MASKT
#undef SEAM_K0
#undef HALF_STEP
}
template <int MODE>
__device__ __forceinline__ void attn_block_s(const BlockRef& cur, lptr lds) {
    constexpr int KROWB = Cfg<MODE>::KROWB, NQF = Cfg<MODE>::NQF, PQ = Cfg<MODE>::PQ, PK = Cfg<MODE>::PK, PV = Cfg<MODE>::PV;
    const int tid = opq_v((int)threadIdx.x), wid = __builtin_amdgcn_readfirstlane(tid >> 6), lane = tid & 63, r32 = lane & 31, hi = lane >> 5;
    const int NT = cur.P0 / KVBLK + QB / KVBLK;
    const int qlo = cur.P0 + wid * QBLK;
    const int qeff = (MODE == 0) ? (qlo | 63) : qlo;
    const int qm = ((MODE == 0) ? (qlo | 63) : (qlo + r32)) - 4 * hi;
    lptr V_lds = lds + OFF_V; lptr K_lds = lds + OFF_K;
    LAS float* ws = (LAS float*)(lds + OFF_WS) + wid * 64; LAS float* li_l = ws; LAS float* al_l = ws + 32;
    LAS float* bias_l = (LAS float*)(lds + OFF_BIAS);
    float m_reg = -1e30f, l_reg = 0; f32x16 o[4] = {};
    const int sr = tid >> 4, sc = (tid & 15) * 8, vst0 = v_st(sr, sc), vst1 = v_st(32 + sr, sc);
    const int kws = sr * KROWB + ((sc * 2) ^ ((sr & 7) << 4));
    const int kwp = (tid >> 3) * KROWB + ((256 + (tid & 7) * 16) ^ (((tid >> 3) & 7) << 4));
    (void)kwp; (void)bias_l;
    const int vb0 = (int)(unsigned)(uintptr_t)V_lds + v_rd_base(lane);
    unsigned kbv[4];
#pragma unroll
    for (int dd = 0; dd < 4; ++dd) kbv[dd] = (unsigned)(uintptr_t)K_lds + r32 * KROWB + (((dd * 16 + hi * 8) * 2) ^ ((r32 & 7) << 4));
    Seam<MODE> S;
#pragma unroll
    for (int d0 = 0; d0 < NQF; ++d0) S.qr[d0] = ld8(cur.Q + (size_t)(wid * QBLK + r32) * PQ + d0 * 16 + hi * 8);
    AT_SLOAD(cur, 0); VMW(); AT_SWRITE(0); SBAR();
    AT_SLOAD(cur, KVBLK);
    __syncthreads();
    f32x16 p0, p1; float mn, al; f16x8 pa0, pa1, pa2, pa3;
#define RESC(a) do { if (__any((a) < 1.f)) { if (hi == 0) al_l[r32] = (a); asm volatile("s_waitcnt lgkmcnt(0)" ::: "memory");              \
                     _Pragma("unroll") for (int d_ = 0; d_ < 4; ++d_) _Pragma("unroll") for (int r = 0; r < 16; ++r) o[d_][r] *= al_l[crow(r, hi)]; } } while (0)
#define BIASADD(P0_, P1_, KBUF) do { if constexpr (MODE == 1) { constexpr float C2 = LOG2E * Cfg<1>::SCALE; const LAS float* bb = bias_l + (KBUF) * 64 + 4 * hi;   \
        _Pragma("unroll") for (int g_ = 0; g_ < 4; ++g_) { const f32x4 ba = *(const LAS f32x4*)(bb + 8 * g_), bc = *(const LAS f32x4*)(bb + 32 + 8 * g_);          \
            _Pragma("unroll") for (int e_ = 0; e_ < 4; ++e_) { P0_[4 * g_ + e_] = fmaf(P0_[4 * g_ + e_], C2, ba[e_]); P1_[4 * g_ + e_] = fmaf(P1_[4 * g_ + e_], C2, bc[e_]); } } } } while (0)
#define STEP(t, BUF) do { SBAR(); qkt2<MODE, BUF>(p0, p1, kbv, S.qr);                                                \
        BIASADD(p0, p1, BUF); { const int kb_ = (t) * KVBLK; if (kb_ + KVBLK - 1 > qeff) mask_tile(p0, p1, qm - kb_); }           \
        partialSM<MODE>(p0, p1, m_reg, mn, al); finishSM(p0, p1, al, l_reg, pa0, pa1, pa2, pa3); RESC(al); SBAR();              \
        pv_tile<BUF>(o, vb0, pa0, pa1, pa2, pa3); SBAR();                                                                      \
        if ((t) + 1 < NT) { VMW(); AT_SWRITE((BUF) ^ 1); SBAR(); if ((t) + 2 < NT) AT_SLOAD(cur, ((t) + 2) * KVBLK); }            \
        __syncthreads(); } while (0)
    for (int t = 0; t < NT; t += 2) { STEP(t, 0); STEP(t + 1, 1); }
#undef STEP
#undef BIASADD
#undef RESC
    if (hi == 0) li_l[r32] = l_reg; asm volatile("s_waitcnt lgkmcnt(0)" ::: "memory");
    LAS h16* ost = (LAS h16*)(lds + wid * 8192);
#pragma unroll
    for (int r = 0; r < 16; ++r) { const float rl = __builtin_amdgcn_rcpf(li_l[crow(r, hi)]); const int orow = crow(r, hi);
#pragma unroll
        for (int d0 = 0; d0 < 4; ++d0) ost[orow * 128 + d0 * 32 + r32] = (h16)(o[d0][r] * rl); }
    asm volatile("s_waitcnt lgkmcnt(0)" ::: "memory");
    h16* Ow = cur.O + (size_t)(wid * QBLK) * D;
#pragma unroll
    for (int i = 0; i < 8; ++i) { const int row = (lane >> 4) + 4 * i, ch = lane & 15;
        *(u32x4*)(Ow + (size_t)row * D + ch * 8) = *(const LAS u32x4*)(ost + row * 128 + ch * 8); }
    __syncthreads();
}
#undef AT_SLOAD
#undef AT_SWRITE_K
#undef AT_SWRITE_V
#undef AT_SWRITE
#undef VMW
#undef VMWN

template <int MODE>
__device__ __forceinline__ BlockRef make_ref(int L, int pass, const h16* Qb, const h16* Kb, const h16* Vb, h16* Ob, const h16* KPb, const float* BIb) {
    constexpr int PQ = Cfg<MODE>::PQ, PK = Cfg<MODE>::PK, PV = Cfg<MODE>::PV, HD = (MODE == 0) ? QKD : 128;
    const int bh = L >> 2, x = L & 3, qb = pass ? (7 - x) : x, b = bh >> 4, h = bh & 15;
    BlockRef r;
    r.Q = Qb + ((size_t)b * SEQ + (size_t)qb * QB) * PQ + h * HD;
    r.K = Kb + (size_t)b * SEQ * PK + h * 128;
    r.V = Vb + (size_t)b * SEQ * PV + h * 128;
    r.O = Ob + ((size_t)b * SEQ + (size_t)qb * QB) * D + h * 128;
    r.KP = KPb + (size_t)b * SEQ * LATP;
    r.BI = BIb + (size_t)bh * SEQ;
    r.P0 = qb * QB;
    return r;
}
template <int MODE, bool PIPE>
__device__ __forceinline__ void attn_phase(lptr lds, int first, int stride, const h16* Qb, const h16* Kb, const h16* Vb, h16* Ob, const h16* KPb, const float* BIb) {
    constexpr int total = BATCH * NHEAD * 4;
    int L = first; if (L >= total) return;
    if constexpr (PIPE) {
        int pass = 0;
        BlockRef cur = make_ref<MODE>(L, 0, Qb, Kb, Vb, Ob, KPb, BIb);
        Seam<MODE> S;
        attn_prime<MODE>(cur, lds, S);
        for (;;) {
            const bool more_pass = pass == 0, more_item = L + stride < total, last = !more_pass && !more_item;
            int passn = pass + 1, Ln = L;
            if (!more_pass) { passn = 0; Ln = more_item ? L + stride : L; }
            const BlockRef nxt = last ? cur : make_ref<MODE>(Ln, passn, Qb, Kb, Vb, Ob, KPb, BIb);
            attn_block<MODE>(cur, nxt, lds, S);
            if (last) break;
            cur = nxt; pass = passn; L = Ln;
        }
    } else {
        for (; L < total; L += stride)
            for (int pass = 0; pass < 2; ++pass) { const BlockRef cur = make_ref<MODE>(L, pass, Qb, Kb, Vb, Ob, KPb, BIb); attn_block_s<MODE>(cur, lds); }
    }
}
}

typedef GAS unsigned gu32;
#define RLX_AGENT __ATOMIC_RELAXED, __HIP_MEMORY_SCOPE_AGENT
#define XB_TMO      128
#define XB_XCNT(j)  (256  + 64 * (j))
#define XB_XSUB(j)  (1280 + 64 * (j))
#define XB_XGEN(j)  (2304 + 64 * (j))
#define XB_TOP      3328
#define XB_TOPGEN   3392
#define XCD_BAR_WORDS 3456
#define XB_SPIN_CAP (1u << 18)
__device__ __forceinline__ unsigned xb_ld(unsigned* p)              { return __hip_atomic_load(p, __ATOMIC_RELAXED, __HIP_MEMORY_SCOPE_AGENT); }
__device__ __forceinline__ unsigned xb_add(unsigned* p, unsigned v) { return __hip_atomic_fetch_add(p, v, __ATOMIC_RELAXED, __HIP_MEMORY_SCOPE_AGENT); }
__device__ __forceinline__ unsigned xb_xcc_id() { return (unsigned)__builtin_amdgcn_s_getreg((3 << 11) | 20) & 0xFu; }
#define XB_SPIN(cond, bar) do { unsigned _sp = 0; while (cond) { __builtin_amdgcn_s_sleep(1); \
    if ((++_sp & 255u) == 0u) { if (xb_ld(&(bar)[XB_TMO])) break; if (_sp > XB_SPIN_CAP) { atomicAdd(&(bar)[XB_TMO], 1u); break; } } } } while (0)
struct XcdBarrier { unsigned* bar; unsigned x; volatile LAS unsigned* st; };
__device__ __forceinline__ XcdBarrier xcd_barrier_post(unsigned* bar, volatile LAS unsigned* st) {
    XcdBarrier b; b.bar = bar; b.x = xb_xcc_id(); b.st = st;
    if (threadIdx.x == 0) (void)xb_add(&bar[XB_XCNT(b.x)], 1u);
    return b;
}
__device__ __forceinline__ void xcd_barrier_complete(unsigned* bar, unsigned x, unsigned& nloc, unsigned& nx) {
    const unsigned G = gridDim.x * gridDim.y * gridDim.z;
    unsigned sum, cnt, mine, sp = 0u;
    for (;;) {
        sum = 0u; cnt = 0u; mine = 0u;
#pragma unroll
        for (unsigned j = 0; j < 16; ++j) { const unsigned c = xb_ld(&bar[XB_XCNT(j)]); sum += c; cnt += (c > 0u) ? 1u : 0u; mine = (j == x) ? c : mine; }
        if (sum == G) break;
        __builtin_amdgcn_s_sleep(1);
        if ((++sp & 255u) == 0u) { if (xb_ld(&bar[XB_TMO])) break; if (sp > XB_SPIN_CAP) { atomicAdd(&bar[XB_TMO], 1u); break; } }
    }
    nloc = mine > 0u ? mine : 1u; nx = cnt > 0u ? cnt : 1u;
}
__device__ __forceinline__ void xcd_barrier(const XcdBarrier& b) {
    asm volatile("s_waitcnt vmcnt(0)" ::: "memory");
    __syncthreads();
    if (threadIdx.x == 0) {
        unsigned* bar = b.bar;
        __builtin_amdgcn_s_waitcnt(0);
        unsigned nloc = b.st[0], nx = b.st[1];
        if (nloc == 0u) { xcd_barrier_complete(bar, b.x, nloc, nx); b.st[0] = nloc; b.st[1] = nx; }
        const unsigned old = xb_add(&bar[XB_XSUB(b.x)], 1u);
        const unsigned gen = old / nloc;
        if (old + 1u == (gen + 1u) * nloc) {
            __builtin_amdgcn_fence(__ATOMIC_RELEASE, "agent");
            asm volatile("s_waitcnt vmcnt(0)" ::: "memory");
            const unsigned og = xb_add(&bar[XB_TOP], 1u);
            const unsigned tg = og / nx;
            if (og + 1u == (tg + 1u) * nx) xb_add(&bar[XB_TOPGEN], 1u);
            else XB_SPIN(xb_ld(&bar[XB_TOPGEN]) == tg, bar);
            __builtin_amdgcn_fence(__ATOMIC_ACQUIRE, "agent");
            xb_add(&bar[XB_XGEN(b.x)], 1u);
            asm volatile("s_waitcnt vmcnt(0)" ::: "memory");
        } else {
            XB_SPIN(xb_ld(&bar[XB_XGEN(b.x)]) == gen, bar);
            __builtin_amdgcn_fence(__ATOMIC_ACQUIRE, "agent");
            asm volatile("s_waitcnt vmcnt(0)" ::: "memory");
        }
    }
    __syncthreads();
}

__device__ __forceinline__ float wave_sum(float v) {
#pragma unroll
    for (int o = 1; o < 64; o <<= 1) v += __shfl_xor(v, o);
    return v;
}
constexpr int CVT_SCR = 128 * 33 * 4;
__device__ __forceinline__ void cvt_item(const float* W, int K, int N, h16* WT, int rowmode, const float* kscale, LAS float* scr, int item, int lane) {
    const int nblk = (N + 31) / 32, kb = item / nblk, nb = item % nblk, k0 = 128 * kb, n0 = 32 * nb;
    const bool nok = (n0 + (lane & 31)) < N;
    const float* src = W + (size_t)(k0 + (lane >> 5)) * N + n0 + (lane & 31);
    float r[64];
#pragma unroll
    for (int i = 0; i < 64; ++i) r[i] = nok ? src[(size_t)(2 * i) * N] : 0.f;
#pragma unroll
    for (int i = 0; i < 64; ++i) scr[(2 * i + (lane >> 5)) * 33 + (lane & 31)] = r[i];
    LDS_WAIT(); asm volatile("" ::: "memory");
    const int c = lane & 15;
    const int drow0 = rowmode >= 0 ? rowmode + n0 : 256 * (n0 >> 7) + (rowmode == -2 ? 128 : 0) + (n0 & 127);
    f32x4 s0 = (f32x4){1.f, 1.f, 1.f, 1.f}, s1 = s0;
    if (kscale) { s0 = *(const f32x4*)(kscale + k0 + 8 * c); s1 = *(const f32x4*)(kscale + k0 + 8 * c + 4); }
#pragma unroll
    for (int j = 0; j < 8; ++j) { const int n = (lane >> 4) + 4 * j; const LAS float* s = scr + (8 * c) * 33 + n;
        u32x4 o; o.x = pkh(s[0 * 33] * s0[0], s[1 * 33] * s0[1]); o.y = pkh(s[2 * 33] * s0[2], s[3 * 33] * s0[3]); o.z = pkh(s[4 * 33] * s1[0], s[5 * 33] * s1[1]); o.w = pkh(s[6 * 33] * s1[2], s[7 * 33] * s1[3]);
        *(u32x4*)(WT + (size_t)(drow0 + n) * K + k0 + 8 * c) = o; }
    LDS_WAIT(); asm volatile("" ::: "memory");
}

__device__ __forceinline__ void fgate_rows(LAS unsigned char* lds, const h16* Hb, const h16* WfT, const float* bf, float* LOGF, int row0) {
    const int tid = opq_v((int)threadIdx.x), lane = tid & 63, wave = __builtin_amdgcn_readfirstlane(tid >> 6), fr = lane & 15, fq = lane >> 4;
    f32x4 acc0 = {0.f, 0.f, 0.f, 0.f}, acc1 = acc0;
    const h16* a0 = Hb + (size_t)(row0 + fr) * D + wave * 256 + 8 * fq; const h16* a1 = a0 + (size_t)16 * D;
    const h16* bp = WfT + (size_t)fr * D + wave * 256 + 8 * fq;
#pragma unroll
    for (int ks = 0; ks < 8; ++ks) { const f16x8 b = *(const f16x8*)(bp + 32 * ks), x0 = *(const f16x8*)(a0 + 32 * ks), x1 = *(const f16x8*)(a1 + 32 * ks);
        acc0 = __builtin_amdgcn_mfma_f32_16x16x32_f16(b, x0, acc0, 0, 0, 0); acc1 = __builtin_amdgcn_mfma_f32_16x16x32_f16(b, x1, acc1, 0, 0, 0); }
    LAS float* red = (LAS float*)lds;
    *(LAS f32x4*)(red + wave * 512 + fr * 16 + 4 * fq) = acc0; *(LAS f32x4*)(red + wave * 512 + (16 + fr) * 16 + 4 * fq) = acc1;
    __syncthreads();
    { float z = bf[tid & 15];
#pragma unroll
      for (int w = 0; w < 8; ++w) z += red[w * 512 + tid];
      LOGF[(size_t)(row0 + (tid >> 4)) * 16 + (tid & 15)] = fminf(z, 0.f) - log1pf(expf(-fabsf(z))); }
    __syncthreads();
}

struct Args {
    const float* x; const float* c; const int* pos; const float* ada_w; const float* ada_b;
    const float* ln1_g; const float* ln1_b; const float* ln2_g; const float* ln2_b;
    const float* w1; const float* w3; const float* w2;
    const float* w_down; const float* q_norm; const float* w_uq; const float* kv_norm; const float* w_uk; const float* w_uv; const float* mla_wo;
    const float* fox_win; const float* fox_bf; const float* fox_wo;
    float* out; unsigned char* ws; int ph_lo, ph_hi;
};

__device__ __forceinline__ void ln_phase(int gw, int NGW, int lane, const h16* V, float* Xo, float* ST, h16* Ho, const float* g, const float* bt, const float* modl, int sc_idx, int sh_idx) {
    for (int m = gw; m < M; m += NGW) {
        const f16x8* vr = (const f16x8*)(V + (size_t)m * D) + lane;
        float v[32]; float s = 0.f;
#pragma unroll
        for (int j = 0; j < 4; ++j) { const f16x8 t = vr[64 * j];
#pragma unroll
            for (int e = 0; e < 8; ++e) { v[8 * j + e] = (float)t[e]; s += v[8 * j + e]; } }
        const float mean = wave_sum(s) * (1.f / D); float s2 = 0.f;
#pragma unroll
        for (int i = 0; i < 32; ++i) { v[i] -= mean; s2 += v[i] * v[i]; }
        const float rstd = 1.f / sqrtf(wave_sum(s2) * (1.f / D) + LN_EPS);
        if (ST && lane == 0) { f32x2 ms = {mean, rstd}; *(f32x2*)(ST + (size_t)m * 2) = ms; }
        const int b = m >> 11;
#pragma unroll
        for (int j = 0; j < 4; ++j) { const int col = 8 * lane + 512 * j;
            const f32x4 g0 = *(const f32x4*)(g + col), g1 = *(const f32x4*)(g + col + 4), b0 = *(const f32x4*)(bt + col), b1 = *(const f32x4*)(bt + col + 4);
            f32x4 y0, y1;
#pragma unroll
            for (int e = 0; e < 4; ++e) { y0[e] = v[8 * j + e] * rstd * g0[e] + b0[e]; y1[e] = v[8 * j + 4 + e] * rstd * g1[e] + b1[e]; }
            if (Xo) { *(f32x4*)(Xo + (size_t)m * D + col) = y0; *(f32x4*)(Xo + (size_t)m * D + col + 4) = y1; }
            if (Ho) { const float* scp = modl + (size_t)b * MODW + sc_idx * D + col; const float* shp = modl + (size_t)b * MODW + sh_idx * D + col;
                const f32x4 h0 = y0 * (*(const f32x4*)scp + 1.0f) + *(const f32x4*)shp, h1 = y1 * (*(const f32x4*)(scp + 4) + 1.0f) + *(const f32x4*)(shp + 4);
                *(u32x4*)(Ho + (size_t)m * D + col) = pk8(h0, h1); } }
    }
}

constexpr int NPHASE = 3 + 8 * NLAYER;

__global__ void __launch_bounds__(NWAVES * 64, 2) trunk_fwd(Args args) {
    extern __shared__ __attribute__((aligned(16))) unsigned char lds_raw[];
    LAS unsigned char* lds = (LAS unsigned char*)lds_raw;
    volatile LAS unsigned* MISC = (volatile LAS unsigned*)(lds + MISC_OFF);
    const int G = gridDim.x; const int bx = blockIdx.x; const int vcu = (G % 8 == 0) ? (bx % 8) * (G / 8) + bx / 8 : bx;
    const int NGW = G * NWAVES;
#define SITE_IDS() const int tid = opq_v((int)threadIdx.x), lane = tid & 63, wave = __builtin_amdgcn_readfirstlane(tid >> 6), gw = vcu * NWAVES + wave; (void)lane; (void)gw
    unsigned char* ws = args.ws;
    unsigned* ctl = (unsigned*)(ws + WS_CTL);
    float* MOD = (float*)(ws + WS_MOD); float* SSP = (float*)(ws + WS_SSP); float* LOGF = (float*)(ws + WS_LOGF); float* BIAS = (float*)(ws + WS_BIAS);
    float* STATS = (float*)(ws + WS_STATS); float* ROPE = (float*)(ws + WS_ROPE); float* MODP = (float*)(ws + WS_MODP); h16* X = (h16*)(ws + WS_X);
    h16* Hb = (h16*)(ws + WS_H); h16* LAT = (h16*)(ws + WS_LAT); h16* Ob = (h16*)(ws + WS_O); h16* QKV = (h16*)(ws + WS_QKV); h16* HH = (h16*)(ws + WS_HH); h16* Wb = (h16*)(ws + WS_W);
    for (int u = threadIdx.x; u < (LDS_BYTES - LDSCTL_OFF) / 4; u += NWAVES * 64) ((LAS unsigned*)(lds + LDSCTL_OFF))[u] = 0u;
    __syncthreads();
    XcdBarrier bar; bar.bar = ctl + CW_BAR; bar.x = 0; bar.st = nullptr;
    if (!MK_PER_PHASE) bar = xcd_barrier_post(ctl + CW_BAR, MISC + 8);
    const int lo = args.ph_lo, hi = args.ph_hi;
#define IN(k) (lo <= (k) && (k) < hi)
#define NREP(K) ((PROBE_DUP == (K)) ? 2 : 1)
#define REP_FOR(K) _Pragma("unroll") for (int rep = 0; rep < NREP(K); ++rep)
#define REP_DUMMY(K) (NREP(K) == 2 && rep == 0)
#define REP_BAR(K) do { if (rep + 1 < NREP(K)) xcd_barrier(bar); } while (0)
    float* DUMX = (float*)(ws + WS_DUMX); h16* DUMH = (h16*)(ws + WS_DUMH); (void)DUMX; (void)DUMH;
#define SEAM(k) do { if (IN((k) + 1)) { if (MK_PER_PHASE) { } else xcd_barrier(bar); } } while (0)

    if (IN(0)) {
        REP_FOR(1) {
        SITE_IDS();
        LAS float* scr = (LAS float*)(lds + wave * CVT_SCR);
        int off = 0;
        for (int job = 0; job < 26; ++job) {
            int kind, idx; if (job < 14) { kind = job % 7; idx = job / 7; } else { kind = 7 + (job - 14) % 3; idx = (job - 14) / 3; }
            const float* src; int K, N, rowmode = 0; h16* dst; const float* ks = nullptr;
            h16* mla = Wb + W_MLA0 + (size_t)idx * W_MLA_SZ; h16* fox = Wb + W_FOX0 + (size_t)idx * W_FOX_SZ; h16* ffn = Wb + W_FFN0 + (size_t)idx * W_FFN_SZ;
            switch (kind) {
                case 0: src = args.w_down + (size_t)idx * D * LATN; K = D; N = LATN; dst = mla; break;
                case 1: src = args.w_uq + (size_t)idx * QL * QN; K = QL; N = QN; dst = mla + W_DOWN_SZ; ks = args.q_norm + idx * QL; break;
                case 2: src = args.w_uk + (size_t)idx * KVL * (NHEAD * NOPE); K = KVL; N = NHEAD * NOPE; dst = mla + W_DOWN_SZ; rowmode = QN; ks = args.kv_norm + idx * KVL; break;
                case 3: src = args.w_uv + (size_t)idx * KVL * (NHEAD * VD); K = KVL; N = NHEAD * VD; dst = mla + W_DOWN_SZ; rowmode = QN + NHEAD * NOPE; ks = args.kv_norm + idx * KVL; break;
                case 4: src = args.mla_wo + (size_t)idx * D * D; K = D; N = D; dst = mla + W_DOWN_SZ + W_UP_SZ; break;
                case 5: src = args.fox_win + (size_t)idx * D * PROJN; K = D; N = PROJN; dst = fox; break;
                case 6: src = args.fox_wo + (size_t)idx * D * D; K = D; N = D; dst = fox + W_IN_SZ; break;
                case 7: src = args.w1 + (size_t)idx * D * FF; K = D; N = FF; dst = ffn; rowmode = -1; break;
                case 8: src = args.w3 + (size_t)idx * D * FF; K = D; N = FF; dst = ffn; rowmode = -2; break;
                default: src = args.w2 + (size_t)idx * FF * D; K = FF; N = D; dst = ffn + W_13_SZ; break;
            }
            const int nitems = (K / 128) * ((N + 31) / 32);
            int first = gw - off; if (first < 0) first += NGW;
            for (int it = first; it < nitems; it += NGW) cvt_item(src, K, N, dst, rowmode, ks, scr, it, lane);
            off = (off + nitems) % NGW;
        }
        {
            const int gt = vcu * (NWAVES * 64) + tid, NT = G * NWAVES * 64;
            constexpr int ZD = (LATP - LATN) * D / 8, ZI = (PROJNP - 6176) * D / 8;
            for (int i = gt; i < 2 * (ZD + ZI); i += NT) {
                const int j = i / (ZD + ZI), r = i % (ZD + ZI);
                h16* p = (r < ZD) ? Wb + W_MLA0 + (size_t)j * W_MLA_SZ + (size_t)LATN * D + (size_t)r * 8
                                  : Wb + W_FOX0 + (size_t)j * W_FOX_SZ + (size_t)6176 * D + (size_t)(r - ZD) * 8;
                *(u32x4*)p = (u32x4){0u, 0u, 0u, 0u};
            }
        }
        __syncthreads();
        {
            LAS float* cact = (LAS float*)lds;
            LAS f32x4* red = (LAS f32x4*)(lds + 4096);
            for (int u = vcu; u < NLAYER * 12 * 16; u += G) {
                const int l = u / 192, r = u % 192, cb = r / 16, kc = r % 16;
                { const int b = tid >> 7, kk = tid & 127; const float cv = args.c[b * D + kc * 128 + kk]; cact[b * 128 + kk] = cv / (1.0f + __expf(-cv)); }
                __syncthreads();
                const int cg = tid & 255, ks = tid >> 8;
                const float* wp = args.ada_w + ((size_t)l * D + kc * 128 + ks * 64) * MODW + cb * 1024 + 4 * cg;
                f32x4 a0 = {0.f, 0.f, 0.f, 0.f}, a1 = a0, a2 = a0, a3 = a0;
#pragma unroll 8
                for (int kk = 0; kk < 64; ++kk) { const f32x4 w = *(const f32x4*)(wp + (size_t)kk * MODW); const int ki = ks * 64 + kk;
                    a0 += w * cact[ki]; a1 += w * cact[128 + ki]; a2 += w * cact[256 + ki]; a3 += w * cact[384 + ki]; }
                if (ks == 1) { red[cg * 4 + 0] = a0; red[cg * 4 + 1] = a1; red[cg * 4 + 2] = a2; red[cg * 4 + 3] = a3; }
                __syncthreads();
                if (ks == 0) { a0 += red[cg * 4 + 0]; a1 += red[cg * 4 + 1]; a2 += red[cg * 4 + 2]; a3 += red[cg * 4 + 3];
                    float* op = MODP + (((size_t)kc * NLAYER + l) * BATCH) * MODW + cb * 1024 + 4 * cg;
                    *(f32x4*)(op) = a0; *(f32x4*)(op + MODW) = a1; *(f32x4*)(op + 2 * MODW) = a2; *(f32x4*)(op + 3 * MODW) = a3; }
                __syncthreads();
            }
        }
        {
            LAS float* invf = (LAS float*)(lds + 65536);
            if (tid < 32) invf[tid] = (float)exp(-(double)tid * (9.210340371976184 / 32.0));
            __syncthreads();
            const int gt = vcu * (NWAVES * 64) + tid, NT = G * NWAVES * 64;
            for (int e = gt; e < M * 32; e += NT) { const int m = e >> 5, i = e & 31;
                const float ang = (float)args.pos[m] * invf[i];
                const double rev = (double)ang * 0.15915494309189535; const float fr = (float)(rev - rint(rev));
                f32x2 cs; cs[0] = __builtin_amdgcn_cosf(fr); cs[1] = __builtin_amdgcn_sinf(fr);
                *(f32x2*)(ROPE + (size_t)e * 2) = cs; }
            __syncthreads();
        }
        REP_BAR(1); }
        SEAM(0);
    }
    if (IN(1)) {
        SITE_IDS();
        const int gt = vcu * (NWAVES * 64) + tid, NT = G * NWAVES * 64;
        for (int e = gt; e < NLAYER * BATCH * MODW; e += NT) { const int l = e / (BATCH * MODW), n = e % MODW;
            float s = args.ada_b[l * MODW + n];
#pragma unroll
            for (int kc = 0; kc < 16; ++kc) s += MODP[(size_t)kc * NLAYER * BATCH * MODW + e];
            MOD[e] = s; }
        SEAM(1);
    }
    if (IN(2)) {
        SITE_IDS();
        for (int m = gw; m < M; m += NGW) { const int b = m >> 11;
#pragma unroll
            for (int j = 0; j < 8; ++j) { const int col = 4 * lane + 256 * j;
                const f32x4 xv = *(const f32x4*)(args.x + (size_t)m * D + col);
                const f32x4 sc = *(const f32x4*)(MOD + (size_t)b * MODW + 1 * D + col), sh = *(const f32x4*)(MOD + (size_t)b * MODW + 0 * D + col);
                const f32x4 hv = xv * (sc + 1.0f) + sh; u32x2 w; w.x = pkh(hv[0], hv[1]); w.y = pkh(hv[2], hv[3]);
                *(u32x2*)(Hb + (size_t)m * D + col) = w; } }
        SEAM(2);
    }

    for (int l_ = 0; l_ < NLAYER; ++l_) {
        const int l = opq_s(l_);
        const int pb = 3 + 8 * l, j = l >> 1;
        const float* modl = MOD + (size_t)l * BATCH * MODW;
        h16* W13 = Wb + W_FFN0 + (size_t)l * W_FFN_SZ; h16* W2 = W13 + W_13_SZ;
        if ((l & 1) == 0) {
            h16* Wd = Wb + W_MLA0 + (size_t)j * W_MLA_SZ; h16* Wu = Wd + W_DOWN_SZ; h16* Wo = Wu + W_UP_SZ;
            h16* Qb = QKV; h16* KVb = QKV + (size_t)M * QN;
            if (IN(pb + 0)) {
                REP_FOR(2) {
                pg8::Gemm g{Hb, Wd, M, LATP, D, D, 1 << 30, 0}; pg8::StaticOrder S; S.init(M, LATP, G, bx);
                pg8::EpiDown E{LAT, SSP, ROPE};
                pg8::gemm_phase<pg8::EpiDown, pg8::StaticOrder, true, true>(lds, g, S, E);
                REP_BAR(2); }
                SEAM(pb + 0);
            }
            if (IN(pb + 1)) {
                REP_FOR(3) {
                pg8::Gemm g{LAT, Wu, M, UPN, QL, LATP, 12, QL}; pg8::StaticOrder S; S.init(M, UPN, G, bx);
                pg8::EpiUp E{Qb, KVb, SSP, ROPE};
                pg8::gemm_phase<pg8::EpiUp, pg8::StaticOrder, true, true>(lds, g, S, E);
                REP_BAR(3); }
                SEAM(pb + 1);
            }
            if (IN(pb + 2)) {
                REP_FOR(4) {
                att::attn_phase<0, false>((att::lptr)lds, vcu, G, Qb, KVb, KVb + NHEAD * NOPE, Ob, LAT + QL + KVL, BIAS);
                REP_BAR(4); }
                SEAM(pb + 2);
            }
            if (IN(pb + 3)) {
                REP_FOR(5) {
                pg8::Gemm g{Ob, Wo, M, D, D, D, 1 << 30, 0}; pg8::StaticOrder S; S.init(M, D, G, bx);
                pg8::EpiRes E{(l == 0) ? args.x : nullptr, X, REP_DUMMY(5) ? DUMH : X, modl + 2 * D, STATS, args.ln2_g + (l - 1) * D, args.ln2_b + (l - 1) * D};
                pg8::gemm_phase<pg8::EpiRes, pg8::StaticOrder, true, true>(lds, g, S, E);
                REP_BAR(5); }
                SEAM(pb + 3);
            }
        } else {
            h16* Wi = Wb + W_FOX0 + (size_t)j * W_FOX_SZ; h16* Wo = Wi + W_IN_SZ;
            if (IN(pb + 0)) {
                REP_FOR(6) {
                pg8::Gemm g{Hb, Wi, M, PROJP, D, D, 1 << 30, 0}; pg8::StaticOrder S; S.init(M, PROJP, G, bx);
                pg8::EpiProj E{QKV};
                pg8::gemm_phase<pg8::EpiProj, pg8::StaticOrder, true, true>(lds, g, S, E);
                for (int rb = vcu; rb < M / 32; rb += G) fgate_rows(lds, Hb, Wi + (size_t)PROJP * D, args.fox_bf + j * NHEAD, LOGF, rb * 32);
                REP_BAR(6); }
                SEAM(pb + 0);
            }
            if (IN(pb + 1)) {
                SITE_IDS();
                LAS float* wsum = (LAS float*)lds;
                for (int u = bx; u < BATCH * NHEAD; u += G) { const int b = u >> 4, h = u & 15;
                    float v[4];
#pragma unroll
                    for (int q = 0; q < 4; ++q) v[q] = LOGF[((size_t)b * SEQ + 4 * tid + q) * 16 + h];
                    v[1] += v[0]; v[2] += v[1]; v[3] += v[2];
                    float inc = v[3];
#pragma unroll
                    for (int d = 1; d < 64; d <<= 1) { const float t = __shfl_up(inc, d); if (lane >= d) inc += t; }
                    if (lane == 63) wsum[wave] = inc;
                    __syncthreads();
                    float base = inc - v[3];
                    for (int w = 0; w < wave; ++w) base += wsum[w];
                    f32x4 o; o[0] = -(base + v[0]) * LOG2E; o[1] = -(base + v[1]) * LOG2E; o[2] = -(base + v[2]) * LOG2E; o[3] = -(base + v[3]) * LOG2E;
                    *(f32x4*)(BIAS + (size_t)u * SEQ + 4 * tid) = o;
                    __syncthreads(); }
                SEAM(pb + 1);
            }
            if (IN(pb + 2)) {
                REP_FOR(7) {
                att::attn_phase<1, false>((att::lptr)lds, vcu, G, QKV, QKV + D, QKV + 2 * D, Ob, LAT, BIAS);
                REP_BAR(7); }
                SEAM(pb + 2);
            }
            if (IN(pb + 3)) {
                REP_FOR(5) {
                pg8::Gemm g{Ob, Wo, M, D, D, D, 1 << 30, 0}; pg8::StaticOrder S; S.init(M, D, G, bx);
                pg8::EpiRes E{(l == 0) ? args.x : nullptr, X, REP_DUMMY(5) ? DUMH : X, modl + 2 * D, STATS, args.ln2_g + (l - 1) * D, args.ln2_b + (l - 1) * D};
                pg8::gemm_phase<pg8::EpiRes, pg8::StaticOrder, true, true>(lds, g, S, E);
                REP_BAR(5); }
                SEAM(pb + 3);
            }
        }
        if (IN(pb + 4)) {
            REP_FOR(8) {
            SITE_IDS();
            ln_phase(gw, NGW, lane, X, nullptr, REP_DUMMY(8) ? DUMX : STATS, REP_DUMMY(8) ? DUMH : Hb, args.ln1_g + l * D, args.ln1_b + l * D, modl, 4, 3);
            REP_BAR(8); }
            SEAM(pb + 4);
        }
        if (IN(pb + 5)) {
            REP_FOR(9) {
            pg8::Gemm g{Hb, W13, M, 2 * FF, D, D, 1 << 30, 0}; pg8::StaticOrder S; S.init(M, 2 * FF, G, bx);
            pg8::EpiSwiglu E{HH};
            pg8::gemm_phase<pg8::EpiSwiglu, pg8::StaticOrder, true, true>(lds, g, S, E);
            REP_BAR(9); }
            SEAM(pb + 5);
        }
        if (IN(pb + 6)) {
            REP_FOR(10) {
            pg8::Gemm g{HH, W2, M, D, FF, FF, 1 << 30, 0}; pg8::StaticOrder S; S.init(M, D, G, bx);
            pg8::EpiRes E{nullptr, X, REP_DUMMY(10) ? DUMH : X, modl + 5 * D, STATS, args.ln1_g + l * D, args.ln1_b + l * D};
            pg8::gemm_phase<pg8::EpiRes, pg8::StaticOrder, true, true>(lds, g, S, E);
            REP_BAR(10); }
            SEAM(pb + 6);
        }
        if (IN(pb + 7)) {
            REP_FOR(8) {
            SITE_IDS();
            if (l + 1 < NLAYER) ln_phase(gw, NGW, lane, X, nullptr, REP_DUMMY(8) ? DUMX : STATS, REP_DUMMY(8) ? DUMH : Hb, args.ln2_g + l * D, args.ln2_b + l * D, modl + (size_t)BATCH * MODW, 1, 0);
            else ln_phase(gw, NGW, lane, X, REP_DUMMY(8) ? DUMX : args.out, nullptr, nullptr, args.ln2_g + l * D, args.ln2_b + l * D, modl, 1, 0);
            REP_BAR(8); }
            SEAM(pb + 7);
        }
    }
#undef IN
#undef SEAM
#undef NREP
#undef REP_FOR
#undef REP_DUMMY
#undef REP_BAR
}

extern "C" void kernel_launch(void* const* d_in, const int* in_sizes, int n_in, void* d_out, int out_size, void* d_ws, size_t ws_size, hipStream_t stream) {
    static int grid = 0;
    if (grid == 0) {
        if (n_in != 22 || in_sizes[0] != M * D || out_size != M * D || ws_size < WS_END) {
            fprintf(stderr, "kernel_launch: shape/workspace mismatch (n_in %d, in0 %d, out %d, ws %zu, need %zu); nothing launched\n", n_in, n_in > 0 ? in_sizes[0] : -1, out_size, ws_size, (size_t)WS_END); grid = -1; return; }
        int dev = 0, cus = 0, per_cu = 0;
        if (hipGetDevice(&dev) != hipSuccess || hipDeviceGetAttribute(&cus, hipDeviceAttributeMultiprocessorCount, dev) != hipSuccess) { grid = -1; return; }
        if (hipFuncSetAttribute((const void*)trunk_fwd, hipFuncAttributeMaxDynamicSharedMemorySize, LDS_BYTES) != hipSuccess) { fprintf(stderr, "kernel_launch: hipFuncSetAttribute failed\n"); grid = -1; return; }
        if (hipOccupancyMaxActiveBlocksPerMultiprocessor(&per_cu, (const void*)trunk_fwd, NWAVES * 64, LDS_BYTES) != hipSuccess || per_cu < 1)
            fprintf(stderr, "kernel_launch: note: occupancy query reports %d workgroups per CU\n", per_cu);
        (void)hipGetLastError();
        grid = cus;
    }
    if (grid < 0) return;
    if (hipMemsetAsync((char*)d_ws + WS_CTL, 0, CTL_ZERO_BYTES, stream) != hipSuccess) return;
    Args a{};
    a.x = (const float*)d_in[0]; a.c = (const float*)d_in[1]; a.pos = (const int*)d_in[2]; a.ada_w = (const float*)d_in[3]; a.ada_b = (const float*)d_in[4];
    a.ln1_g = (const float*)d_in[5]; a.ln1_b = (const float*)d_in[6]; a.ln2_g = (const float*)d_in[7]; a.ln2_b = (const float*)d_in[8];
    a.w1 = (const float*)d_in[9]; a.w3 = (const float*)d_in[10]; a.w2 = (const float*)d_in[11];
    a.w_down = (const float*)d_in[12]; a.q_norm = (const float*)d_in[13]; a.w_uq = (const float*)d_in[14]; a.kv_norm = (const float*)d_in[15];
    a.w_uk = (const float*)d_in[16]; a.w_uv = (const float*)d_in[17]; a.mla_wo = (const float*)d_in[18];
    a.fox_win = (const float*)d_in[19]; a.fox_bf = (const float*)d_in[20]; a.fox_wo = (const float*)d_in[21];
    a.out = (float*)d_out; a.ws = (unsigned char*)d_ws;
#if MK_PER_PHASE
    for (int p = 0; p < NPHASE; ++p) { a.ph_lo = p; a.ph_hi = p + 1; hipLaunchKernelGGL(trunk_fwd, dim3(grid), dim3(NWAVES * 64), LDS_BYTES, stream, a); }
#else
    a.ph_lo = 0; a.ph_hi = NPHASE;
    hipLaunchKernelGGL(trunk_fwd, dim3(grid), dim3(NWAVES * 64), LDS_BYTES, stream, a);
#endif
    const hipError_t le = hipPeekAtLastError();
    if (le != hipSuccess) fprintf(stderr, "kernel_launch: launch failed: %s\n", hipGetErrorName(le));
}
```

```cpp
#include <hip/hip_runtime.h>
#include <cstdio>
#include <cstdint>

#ifndef PROBE_DUP
#define PROBE_DUP 0
#endif
#ifndef MK_PER_PHASE
#define MK_PER_PHASE 0
#endif

#define LAS __attribute__((address_space(3)))
#define GAS __attribute__((address_space(1)))
typedef _Float16 h16;
typedef _Float16 f16x8 __attribute__((ext_vector_type(8)));
typedef _Float16 f16x2 __attribute__((ext_vector_type(2)));
typedef short s16x4 __attribute__((ext_vector_type(4)));
typedef float f32x2 __attribute__((ext_vector_type(2)));
typedef float f32x4 __attribute__((ext_vector_type(4)));
typedef float f32x16 __attribute__((ext_vector_type(16)));
typedef unsigned u32x2 __attribute__((ext_vector_type(2)));
typedef unsigned u32x4 __attribute__((ext_vector_type(4)));

constexpr int BATCH = 4, SEQ = 2048, M = BATCH * SEQ, D = 2048, NLAYER = 4, FF = 5632;
constexpr int NHEAD = 16, QL = 512, KVL = 512, ROPE_D = 64, NOPE = 128, VD = 128, QKD = NOPE + ROPE_D;
constexpr int LATN = QL + KVL + ROPE_D, LATP = 1280;
constexpr int QN = NHEAD * QKD, KVN = 2 * NHEAD * NOPE, UPN = QN + KVN;
constexpr int PROJN = 3 * D + NHEAD, PROJNP = 6400, PROJP = 3 * D;
constexpr int MODW = 6 * D;
constexpr float DN_ALPHA = 1.6817928305074290f;
constexpr float LN_EPS = 1e-5f, RMS_EPS = 1e-6f;
constexpr float LOG2E = 1.4426950408889634f;

constexpr size_t MiB = 1u << 20;
constexpr size_t WS_CTL = 0, CTL_ZERO_BYTES = 1 * MiB;
constexpr size_t WS_MOD = 1 * MiB;
constexpr size_t WS_SSP = 2 * MiB;
constexpr size_t WS_LOGF = 3 * MiB;
constexpr size_t WS_BIAS = 4 * MiB;
constexpr size_t WS_ROPE = 5 * MiB;
constexpr size_t WS_STATS = 7 * MiB;
constexpr size_t WS_MODP = 8 * MiB;
constexpr size_t WS_X = 24 * MiB;
constexpr size_t WS_H = 88 * MiB;
constexpr size_t WS_LAT = 120 * MiB;
constexpr size_t WS_O = 140 * MiB;
constexpr size_t WS_QKV = 172 * MiB;
constexpr size_t WS_KVOFF = (size_t)M * QN * 2;
constexpr size_t WS_HH = 284 * MiB;
constexpr size_t WS_W = 372 * MiB;
constexpr size_t W_DOWN_SZ = (size_t)LATP * D, W_UP_SZ = (size_t)UPN * QL, W_O_SZ = (size_t)D * D, W_IN_SZ = (size_t)PROJNP * D, W_13_SZ = (size_t)2 * FF * D, W_2_SZ = (size_t)D * FF;
constexpr size_t W_MLA_SZ = W_DOWN_SZ + W_UP_SZ + W_O_SZ, W_FOX_SZ = W_IN_SZ + W_O_SZ, W_FFN_SZ = W_13_SZ + W_2_SZ;
constexpr size_t W_MLA0 = 0, W_FOX0 = 2 * W_MLA_SZ, W_FFN0 = W_FOX0 + 2 * W_FOX_SZ, W_TOTAL = W_FFN0 + 4 * W_FFN_SZ;
constexpr size_t WS_WEND = WS_W + W_TOTAL * 2;
#if PROBE_DUP
constexpr size_t WS_DUMX = (WS_WEND + MiB - 1) / MiB * MiB, WS_DUMH = WS_DUMX + 64 * MiB, WS_END = WS_DUMH + 32 * MiB;
#else
constexpr size_t WS_DUMX = WS_X, WS_DUMH = WS_H, WS_END = WS_WEND;
#endif

constexpr int CW_BAR = 4096;

constexpr int RING_BYTES = 139264;
constexpr int LDSCTL_OFF = RING_BYTES, MISC_OFF = LDSCTL_OFF + 320;
constexpr int LDS_BYTES = 147456;
constexpr int NWAVES = 8;

#define LDS_WAIT() asm volatile("s_waitcnt lgkmcnt(0)" ::: "memory")
#define VM_WAIT() asm volatile("s_waitcnt vmcnt(0)" ::: "memory")

__device__ __forceinline__ int opq_v(int v) { asm volatile("" : "+v"(v)); return v; }
__device__ __forceinline__ int opq_s(int v) { asm volatile("" : "+s"(v)); return v; }
__device__ __forceinline__ unsigned pkh(float lo, float hi) { f16x2 v = {(h16)lo, (h16)hi}; return __builtin_bit_cast(unsigned, v); }
__device__ __forceinline__ u32x4 pk8(f32x4 a, f32x4 b) { u32x4 w; w.x = pkh(a[0], a[1]); w.y = pkh(a[2], a[3]); w.z = pkh(b[0], b[1]); w.w = pkh(b[2], b[3]); return w; }

namespace pg8 {
constexpr int BM = 256, BK = 64, HALF = 128, HTB = HALF * BK * 2, STAGE_BYTES = 8 * HTB, NXCD = 8, WGM = 8;
__host__ __device__ __forceinline__ int lds_byte(int r, int c) { const int st = (r >> 4) * 2 + (c >> 5), rr = r & 15, cc = c & 31, ob = rr * 64 + cc * 2; return st * 1024 + (ob ^ (((ob >> 9) & 1) << 5)); }
__host__ __device__ __forceinline__ void stage_rc(int b, int& R, int& C) { const int st = b / 1024, sb = b % 1024, swz = sb ^ (((sb >> 9) & 1) << 5); R = (st >> 1) * 16 + swz / 64; C = (st & 1) * 32 + (swz % 64) / 2; }
__host__ __device__ __forceinline__ int perm32(int rho) { const int n = rho >> 4, i = rho & 15; return 8 * (i >> 2) + 4 * n + (i & 3); }

struct Unit { int pm, pn; };
struct Gemm { const h16* A; const h16* Bt; int M, N, K, lda; int split_pn, split_off; };

struct StaticOrder {
    int nM, nN, nwg, G, c;
    __device__ void init(int M_, int N_, int G_, int c_) { nM = M_ / BM; nN = N_ / BM; nwg = nM * nN; G = G_; c = c_; }
    __device__ bool next(int i, Unit& u) const {
        const long L = (long)i * G + c; if (L >= nwg) return false;
        int wgid = (int)L; { const int q = nwg / NXCD, r = nwg % NXCD, xcd = wgid % NXCD, off = wgid / NXCD; wgid = (xcd < r ? xcd * (q + 1) : r * (q + 1) + (xcd - r) * q) + off; }
        const int nig = WGM * nN, gid = wgid / nig, fm = gid * WGM, gsz = (nM - fm) < WGM ? (nM - fm) : WGM;
        u.pm = fm + ((wgid % nig) % gsz); u.pn = (wgid % nig) / gsz; return true;
    }
};

typedef f32x4 Acc[2][2][4][2];

template <class Epi, class Sched, bool ALIGN_EPI, bool SP2>
__device__ __forceinline__ void gemm_phase(LAS unsigned char* lds, const Gemm g, const Sched& S, const Epi& E) {
    const int tid = opq_v((int)threadIdx.x), wid = __builtin_amdgcn_readfirstlane(tid >> 6), lane = tid & 63, wr = wid >> 2, wc = wid & 3, fr = lane & 15, fq = lane >> 4;
    const int K = g.K, nt = K / BK, lda = g.lda;
    unsigned voffA[2], voffB[2];
#pragma unroll
    for (int i = 0; i < 2; ++i) { int R, C; stage_rc(tid * 16 + i * 8192, R, C); const int Rb = Epi::PERM ? ((R & ~31) + perm32(R & 31)) : R;
        voffA[i] = (unsigned)(R * lda + C) * 2u; voffB[i] = (unsigned)(Rb * K + C) * 2u; }
    const size_t kstep = (size_t)(BK * 2);
    const size_t hstepA = (size_t)HALF * lda * 2, hstepB = (size_t)HALF * K * 2;
    const size_t tstepA = 2 * hstepA, tstepB = 2 * hstepB;
    const unsigned ldsw = (unsigned)wid * 1024u;
    const int aoff = lds_byte(wr * 64 + fr, fq * 8), boff = lds_byte(wc * 32 + fr, fq * 8);
#define PG8_SA(b, h) (((b) * 2 + (h)) * HTB)
#define PG8_SB(b, h) ((4 + (b) * 2 + (h)) * HTB)
#define PG8_STAGE(bufoff, gbase, voff) do { _Pragma("unroll") for (int _i = 0; _i < 2; ++_i) \
        __builtin_amdgcn_global_load_lds((const unsigned*)((const char*)(gbase) + (voff)[_i]), (LAS unsigned*)(lds + (bufoff) + ldsw + _i * 8192), 16, 0, 0); } while (0)
#define PG8_LDA(dst, b, h) do { _Pragma("unroll") for (int m = 0; m < 4; ++m) _Pragma("unroll") for (int k = 0; k < 2; ++k) dst[m][k] = *(const LAS f16x8*)(lds + PG8_SA(b, h) + aoff + m * 2048 + k * 1024); } while (0)
#define PG8_LDB(dst, b, h) do { _Pragma("unroll") for (int n = 0; n < 2; ++n) _Pragma("unroll") for (int k = 0; k < 2; ++k) dst[n][k] = *(const LAS f16x8*)(lds + PG8_SB(b, h) + boff + n * 2048 + k * 1024); } while (0)
#define PG8_MMA(ai, bj, At, Bt) do { __builtin_amdgcn_s_setprio(1); _Pragma("unroll") for (int m = 0; m < 4; ++m) _Pragma("unroll") for (int n = 0; n < 2; ++n) _Pragma("unroll") for (int k = 0; k < 2; ++k) \
        acc[ai][bj][m][n] = __builtin_amdgcn_mfma_f32_16x16x32_f16(Bt[n][k], At[m][k], acc[ai][bj][m][n], 0, 0, 0); __builtin_amdgcn_s_setprio(0); } while (0)
#define PG8_WAIT_V(n) asm volatile("s_waitcnt vmcnt(" #n ")" ::: "memory")
#define PG8_WAIT_L(n) asm volatile("s_waitcnt lgkmcnt(" #n ")" ::: "memory")
#define PG8_BAR __builtin_amdgcn_s_barrier()
#define PG8_SCHED __builtin_amdgcn_sched_barrier(0)
#define PG8_AOFF(u) ((size_t)(u).pm * tstepA + ((u).pn >= g.split_pn ? (size_t)g.split_off * 2 : (size_t)0))
    Unit cur, nxt; int ui = 0;
    if (!S.next(0, cur)) return;
    Acc acc;
#pragma unroll
    for (int a = 0; a < 2; ++a)
#pragma unroll
        for (int b = 0; b < 2; ++b)
#pragma unroll
            for (int m = 0; m < 4; ++m)
#pragma unroll
                for (int n = 0; n < 2; ++n) acc[a][b][m][n] = (f32x4){0.f, 0.f, 0.f, 0.f};
    f16x8 At[4][2], B0[2][2], B1[2][2];
    const char* cA = (const char*)g.A + PG8_AOFF(cur); const char* cB = (const char*)g.Bt + (size_t)cur.pn * tstepB;
    if constexpr (SP2) {
        PG8_STAGE(PG8_SB(0, 0), cB, voffB); PG8_STAGE(PG8_SB(0, 1), cB + hstepB, voffB); PG8_STAGE(PG8_SA(0, 0), cA, voffA); PG8_STAGE(PG8_SA(0, 1), cA + hstepA, voffA);
        if (wr == 1) PG8_BAR;
        PG8_WAIT_V(2); PG8_BAR;
        PG8_STAGE(PG8_SB(1, 0), cB + kstep, voffB); PG8_STAGE(PG8_SA(1, 0), cA + kstep, voffA); PG8_STAGE(PG8_SB(1, 1), cB + hstepB + kstep, voffB);
        PG8_WAIT_V(6); PG8_BAR;
    } else {
        PG8_STAGE(PG8_SB(0, 0), cB, voffB); PG8_STAGE(PG8_SA(0, 0), cA, voffA); PG8_STAGE(PG8_SB(0, 1), cB + hstepB, voffB); PG8_STAGE(PG8_SA(0, 1), cA + hstepA, voffA);
        if (wr == 1) PG8_BAR;
        PG8_WAIT_V(4); PG8_BAR;
        PG8_STAGE(PG8_SB(1, 0), cB + kstep, voffB); PG8_STAGE(PG8_SA(1, 0), cA + kstep, voffA); PG8_STAGE(PG8_SB(1, 1), cB + hstepB + kstep, voffB);
        PG8_WAIT_V(6); PG8_BAR;
    }
    for (;;) {
        const bool has_next = S.next(ui + 1, nxt);
        const char* nA = has_next ? (const char*)g.A + PG8_AOFF(nxt) : cA; const char* nB = has_next ? (const char*)g.Bt + (size_t)nxt.pn * tstepB : cB;
        for (int t = 0; t < nt; t += 2) {
            const bool last = (t == nt - 2);
            const char* a1 = cA + (size_t)(t + 1) * kstep;
            const char* a2 = last ? nA : cA + (size_t)(t + 2) * kstep; const char* b2 = last ? nB : cB + (size_t)(t + 2) * kstep;
            const char* a3 = a2 + kstep; const char* b3 = b2 + kstep;
            if constexpr (SP2) {
            PG8_LDB(B0, 0, 0); PG8_LDB(B1, 0, 1); PG8_SCHED; PG8_LDA(At, 0, 0); PG8_STAGE(PG8_SA(1, 1), a1 + hstepA, voffA);
            PG8_WAIT_V(8); PG8_WAIT_L(0); PG8_BAR; PG8_MMA(0, 0, At, B0); PG8_MMA(0, 1, At, B1); PG8_BAR; PG8_SCHED;
            PG8_LDA(At, 0, 1); PG8_STAGE(PG8_SB(0, 0), b2, voffB); PG8_STAGE(PG8_SB(0, 1), b2 + hstepB, voffB); PG8_STAGE(PG8_SA(0, 0), a2, voffA);
            PG8_WAIT_V(8); PG8_WAIT_L(0); PG8_BAR; PG8_MMA(1, 0, At, B0); PG8_MMA(1, 1, At, B1); PG8_BAR; PG8_SCHED;
            PG8_LDB(B0, 1, 0); PG8_LDB(B1, 1, 1); PG8_SCHED; PG8_LDA(At, 1, 0); PG8_STAGE(PG8_SA(0, 1), a2 + hstepA, voffA);
            PG8_WAIT_V(8); PG8_WAIT_L(0); PG8_BAR; PG8_MMA(0, 0, At, B0); PG8_MMA(0, 1, At, B1); PG8_BAR; PG8_SCHED;
            PG8_LDA(At, 1, 1); PG8_STAGE(PG8_SB(1, 0), b3, voffB); PG8_STAGE(PG8_SB(1, 1), b3 + hstepB, voffB); PG8_STAGE(PG8_SA(1, 0), a3, voffA);
            PG8_WAIT_V(8); PG8_WAIT_L(0); PG8_BAR; PG8_MMA(1, 0, At, B0); PG8_MMA(1, 1, At, B1); PG8_BAR; PG8_SCHED;
            } else {
            PG8_LDB(B0, 0, 0); PG8_SCHED; PG8_LDA(At, 0, 0); PG8_STAGE(PG8_SA(1, 1), a1 + hstepA, voffA);
            PG8_WAIT_L(8); PG8_BAR; PG8_WAIT_L(0); PG8_MMA(0, 0, At, B0); PG8_BAR; PG8_SCHED;
            PG8_LDB(B1, 0, 1); PG8_STAGE(PG8_SB(0, 0), b2, voffB);
            PG8_BAR; PG8_WAIT_L(0); PG8_MMA(0, 1, At, B1); PG8_BAR;
            PG8_LDA(At, 0, 1); PG8_STAGE(PG8_SA(0, 0), a2, voffA);
            PG8_BAR; PG8_WAIT_L(0); PG8_MMA(1, 0, At, B0); PG8_BAR; PG8_SCHED;
            PG8_STAGE(PG8_SB(0, 1), b2 + hstepB, voffB);
            PG8_WAIT_V(6); PG8_BAR; PG8_MMA(1, 1, At, B1); PG8_BAR;
            PG8_LDB(B0, 1, 0); PG8_SCHED; PG8_LDA(At, 1, 0); PG8_STAGE(PG8_SA(0, 1), a2 + hstepA, voffA);
            PG8_WAIT_L(8); PG8_BAR; PG8_WAIT_L(0); PG8_MMA(0, 0, At, B0); PG8_BAR; PG8_SCHED;
            PG8_LDB(B1, 1, 1); PG8_STAGE(PG8_SB(1, 0), b3, voffB);
            PG8_BAR; PG8_WAIT_L(0); PG8_MMA(0, 1, At, B1); PG8_BAR;
            PG8_LDA(At, 1, 1); PG8_STAGE(PG8_SA(1, 0), a3, voffA);
            PG8_BAR; PG8_WAIT_L(0); PG8_MMA(1, 0, At, B0); PG8_BAR; PG8_SCHED;
            PG8_STAGE(PG8_SB(1, 1), b3 + hstepB, voffB);
            PG8_WAIT_V(6); PG8_BAR; PG8_MMA(1, 1, At, B1); PG8_BAR;
            }
        }
        if constexpr (ALIGN_EPI) { if (wr == 0) PG8_BAR; }
        E(acc, cur, wr, wc, fr, fq);
        if (!has_next) break;
#pragma unroll
        for (int a = 0; a < 2; ++a)
#pragma unroll
            for (int b = 0; b < 2; ++b)
#pragma unroll
                for (int m = 0; m < 4; ++m)
#pragma unroll
                    for (int n = 0; n < 2; ++n) acc[a][b][m][n] = (f32x4){0.f, 0.f, 0.f, 0.f};
        cur = nxt; cA = nA; cB = nB; ++ui;
        if constexpr (ALIGN_EPI) { if (wr == 1) PG8_BAR; }
    }
    PG8_WAIT_V(0);
    if constexpr (!ALIGN_EPI) { if (wr == 0) PG8_BAR; }
    PG8_BAR;
#undef PG8_SA
#undef PG8_SB
#undef PG8_STAGE
#undef PG8_LDA
#undef PG8_LDB
#undef PG8_MMA
#undef PG8_WAIT_V
#undef PG8_WAIT_L
#undef PG8_BAR
#undef PG8_SCHED
#undef PG8_AOFF
}

__device__ __forceinline__ void rope4(f32x4& v0, f32x4& v1, const float* cs) {
    const f32x4 a = *(const f32x4*)cs, b = *(const f32x4*)(cs + 4);
    f32x4 o0, o1;
    o0[0] = v0[0] * a[0] - v0[1] * a[1]; o0[1] = v0[0] * a[1] + v0[1] * a[0];
    o0[2] = v0[2] * a[2] - v0[3] * a[3]; o0[3] = v0[2] * a[3] + v0[3] * a[2];
    o1[0] = v1[0] * b[0] - v1[1] * b[1]; o1[1] = v1[0] * b[1] + v1[1] * b[0];
    o1[2] = v1[2] * b[2] - v1[3] * b[3]; o1[3] = v1[2] * b[3] + v1[3] * b[2];
    v0 = o0; v1 = o1;
}
struct EpiDown {
    static constexpr bool PERM = true;
    h16* LAT; float* SSP; const float* ROPE;
    __device__ __forceinline__ void operator()(const Acc& acc, const Unit& u, int wr, int wc, int fr, int fq) const {
        const int col0 = u.pn * BM + wc * 32 + 8 * fq;
#pragma unroll
        for (int ai = 0; ai < 2; ++ai)
#pragma unroll
            for (int m = 0; m < 4; ++m) {
                const int row = u.pm * BM + ai * HALF + wr * 64 + m * 16 + fr; float ss = 0.f;
#pragma unroll
                for (int bj = 0; bj < 2; ++bj) { f32x4 v0 = acc[ai][bj][m][0], v1 = acc[ai][bj][m][1];
                    ss += (v0[0] * v0[0] + v0[1] * v0[1]) + (v0[2] * v0[2] + v0[3] * v0[3]) + (v1[0] * v1[0] + v1[1] * v1[1]) + (v1[2] * v1[2] + v1[3] * v1[3]);
                    if (u.pn == 4 && bj == 0 && wc < 2) rope4(v0, v1, ROPE + ((size_t)row * 32 + 16 * wc + 4 * fq) * 2);
                    *(u32x4*)(LAT + (size_t)row * LATP + col0 + bj * HALF) = pk8(v0, v1); }
                if (u.pn < 4) { ss += __shfl_xor(ss, 16); ss += __shfl_xor(ss, 32); if (fq == 0) SSP[(size_t)row * 16 + u.pn * 4 + wc] = ss; }
            }
    }
};
struct EpiUp {
    static constexpr bool PERM = true;
    h16* Q; h16* KV; const float* SSP; const float* ROPE;
    __device__ __forceinline__ void operator()(const Acc& acc, const Unit& u, int wr, int wc, int fr, int fq) const {
        const bool isq = u.pn < 12;
        const int colt = (isq ? u.pn : u.pn - 12) * BM + wc * 32 + 8 * fq;
#pragma unroll
        for (int ai = 0; ai < 2; ++ai)
#pragma unroll
            for (int m = 0; m < 4; ++m) {
                const int row = u.pm * BM + ai * HALF + wr * 64 + m * 16 + fr;
                const f32x4* sp = (const f32x4*)(SSP + (size_t)row * 16 + (isq ? 0 : 8)); const f32x4 s0 = sp[0], s1 = sp[1];
                const float ss = ((s0[0] + s0[1]) + (s0[2] + s0[3])) + ((s1[0] + s1[1]) + (s1[2] + s1[3]));
                const float rstd = 1.0f / sqrtf(ss * (1.0f / 512.0f) + RMS_EPS);
#pragma unroll
                for (int bj = 0; bj < 2; ++bj) { f32x4 v0 = acc[ai][bj][m][0] * rstd, v1 = acc[ai][bj][m][1] * rstd; const int col = colt + bj * HALF;
                    if (isq) { const int within = col % QKD;
                        if (within >= NOPE) rope4(v0, v1, ROPE + ((size_t)row * 32 + ((within - NOPE) >> 1)) * 2);
                        *(u32x4*)(Q + (size_t)row * QN + col) = pk8(v0, v1); }
                    else *(u32x4*)(KV + (size_t)row * KVN + col) = pk8(v0, v1); }
            }
    }
};
struct EpiProj {
    static constexpr bool PERM = true;
    h16* P;
    __device__ __forceinline__ void operator()(const Acc& acc, const Unit& u, int wr, int wc, int fr, int fq) const {
        const int col0 = u.pn * BM + wc * 32 + 8 * fq;
#pragma unroll
        for (int ai = 0; ai < 2; ++ai)
#pragma unroll
            for (int m = 0; m < 4; ++m) { const int row = u.pm * BM + ai * HALF + wr * 64 + m * 16 + fr;
#pragma unroll
                for (int bj = 0; bj < 2; ++bj) *(u32x4*)(P + (size_t)row * PROJP + col0 + bj * HALF) = pk8(acc[ai][bj][m][0], acc[ai][bj][m][1]); }
    }
};
struct EpiSwiglu {
    static constexpr bool PERM = true;
    h16* HH;
    __device__ __forceinline__ void operator()(const Acc& acc, const Unit& u, int wr, int wc, int fr, int fq) const {
        const int col0 = u.pn * HALF + wc * 32 + 8 * fq;
#pragma unroll
        for (int ai = 0; ai < 2; ++ai)
#pragma unroll
            for (int m = 0; m < 4; ++m) { const int row = u.pm * BM + ai * HALF + wr * 64 + m * 16 + fr; f32x4 h0, h1;
#pragma unroll
                for (int e = 0; e < 4; ++e) { const float g0 = acc[ai][0][m][0][e], g1 = acc[ai][0][m][1][e];
                    h0[e] = g0 * __builtin_amdgcn_rcpf(1.0f + __expf(-g0)) * acc[ai][1][m][0][e]; h1[e] = g1 * __builtin_amdgcn_rcpf(1.0f + __expf(-g1)) * acc[ai][1][m][1][e]; }
                *(u32x4*)(HH + (size_t)row * FF + col0) = pk8(h0, h1); }
    }
};
struct EpiRes {
    static constexpr bool PERM = true;
    const float* xin32; const h16* xin16; h16* X; const float* gate; const float* st; const float* lg; const float* lb;
    __device__ __forceinline__ void operator()(const Acc& acc, const Unit& u, int wr, int wc, int fr, int fq) const {
        const int col0 = u.pn * BM + wc * 32 + 8 * fq; const float* gp = gate + (size_t)(u.pm >> 3) * MODW + col0;
        f32x4 gv[2][2], lgv[2][2], lbv[2][2];
#pragma unroll
        for (int bj = 0; bj < 2; ++bj)
#pragma unroll
            for (int n = 0; n < 2; ++n) { gv[bj][n] = *(const f32x4*)(gp + bj * HALF + 4 * n) + 1.0f;
                if (!xin32) { lgv[bj][n] = *(const f32x4*)(lg + col0 + bj * HALF + 4 * n) * DN_ALPHA; lbv[bj][n] = *(const f32x4*)(lb + col0 + bj * HALF + 4 * n) * DN_ALPHA; } }
#pragma unroll
        for (int ai = 0; ai < 2; ++ai)
#pragma unroll
            for (int m = 0; m < 4; ++m) { const int row = u.pm * BM + ai * HALF + wr * 64 + m * 16 + fr; const size_t off = (size_t)row * D + col0;
                f32x2 ms = {0.f, 0.f}; if (!xin32) ms = *(const f32x2*)(st + (size_t)row * 2);
#pragma unroll
                for (int bj = 0; bj < 2; ++bj) { f32x4 xa0, xa1;
                    if (xin32) { xa0 = *(const f32x4*)(xin32 + off + bj * HALF) * DN_ALPHA; xa1 = *(const f32x4*)(xin32 + off + bj * HALF + 4) * DN_ALPHA; }
                    else { const f16x8 xv = *(const f16x8*)(xin16 + off + bj * HALF);
                        f32x4 x0 = {(float)xv[0], (float)xv[1], (float)xv[2], (float)xv[3]}, x1 = {(float)xv[4], (float)xv[5], (float)xv[6], (float)xv[7]};
                        xa0 = (x0 - ms[0]) * ms[1] * lgv[bj][0] + lbv[bj][0]; xa1 = (x1 - ms[0]) * ms[1] * lgv[bj][1] + lbv[bj][1]; }
                    *(u32x4*)(X + off + bj * HALF) = pk8(xa0 + gv[bj][0] * acc[ai][bj][m][0], xa1 + gv[bj][1] * acc[ai][bj][m][1]); } }
    }
};
}

namespace att {
constexpr int NW = 8, QBLK = 32, KVBLK = 64, QB = NW * QBLK;
constexpr int SHM_V = KVBLK * 128 * 2;
constexpr int SHM_KMAX = KVBLK * 512;
constexpr int OFF_V = 0, OFF_K = 2 * SHM_V, OFF_WS = OFF_K + 2 * SHM_KMAX, OFF_BIAS = OFF_WS + NW * 64 * 4, ATT_LDS = OFF_BIAS + 2 * 64 * 4;
static_assert(ATT_LDS <= RING_BYTES, "attention LDS");
constexpr float THR = 8.f;
#define SBAR() __builtin_amdgcn_sched_barrier(0)
typedef LAS char* lptr;
__device__ __forceinline__ int v_st(int k, int c) { const int kk = (k & ~0xC) | ((k & 4) << 1) | ((k & 8) >> 1); return ((kk >> 3) * 4 + (c >> 5)) * 512 + ((kk & 7) * 32 + (c & 31)) * 2; }
__device__ __forceinline__ int v_rd_base(int lane) { return ((lane & 3) << 3) | (((lane >> 2) & 3) << 6) | (((lane >> 4) & 1) << 5) | (((lane >> 5) & 1) << 8); }
constexpr int v_rd_off(int d0, int ks, int half) { return d0 * 512 + ks * 4096 + half * 2048; }
__device__ __forceinline__ int crow(int r, int hi) { return (r & 3) + 8 * (r >> 2) + 4 * hi; }
__device__ __forceinline__ f16x8 ld8(const h16* p) { return *reinterpret_cast<const f16x8*>(p); }

template <int MODE> struct Cfg;
template <> struct Cfg<0> { static constexpr int KROWB = 512, NQF = 12, PQ = QN, PK = KVN, PV = KVN; static constexpr float SCALE = 0.07216878364870322f; };
template <> struct Cfg<1> { static constexpr int KROWB = 256, NQF = 8, PQ = PROJP, PK = PROJP, PV = PROJP; static constexpr float SCALE = 0.08838834764831845f; };

__device__ __forceinline__ void mask_tile(f32x16& p0, f32x16& p1, int dq) {
    const float NEG = -__builtin_inff();
#pragma unroll
    for (int r = 0; r < 16; ++r) { const int c = (r & 3) + 8 * (r >> 2);
        if (dq - c < 0) p0[r] = NEG;
        if (dq - c - 32 < 0) p1[r] = NEG; }
}
template <int MODE>
__device__ __forceinline__ void partialSM(f32x16& p0, f32x16& p1, float& m_reg, float& mn, float& alpha) {
    float pmax = p0[0];
#pragma unroll
    for (int r = 1; r < 16; ++r) pmax = fmaxf(pmax, p0[r]);
#pragma unroll
    for (int r = 0; r < 16; ++r) pmax = fmaxf(pmax, p1[r]);
    { auto rr = __builtin_amdgcn_permlane32_swap(__float_as_uint(pmax), __float_as_uint(pmax), false, false);
      pmax = fmaxf(__uint_as_float(rr[0]), __uint_as_float(rr[1])); }
    if constexpr (MODE == 0) {
        constexpr float SC = Cfg<0>::SCALE, C2 = LOG2E * SC;
        if (__builtin_expect(__all((pmax - m_reg) * SC <= THR), 1)) { mn = m_reg; alpha = 1.f; }
        else { mn = fmaxf(m_reg, pmax); alpha = __builtin_amdgcn_exp2f((m_reg - mn) * C2); m_reg = mn; }
        const float mnL = -mn * C2;
#pragma unroll
        for (int r = 0; r < 16; ++r) p0[r] = fmaf(p0[r], C2, mnL);
#pragma unroll
        for (int r = 0; r < 16; ++r) p1[r] = fmaf(p1[r], C2, mnL);
    } else {
        if (__builtin_expect(__all((pmax - m_reg) <= THR * LOG2E), 1)) { mn = m_reg; alpha = 1.f; }
        else { mn = fmaxf(m_reg, pmax); alpha = __builtin_amdgcn_exp2f(m_reg - mn); m_reg = mn; }
#pragma unroll
        for (int r = 0; r < 16; ++r) p0[r] = p0[r] - mn;
#pragma unroll
        for (int r = 0; r < 16; ++r) p1[r] = p1[r] - mn;
    }
#pragma unroll
    for (int r = 0; r < 16; ++r) p0[r] = __builtin_amdgcn_exp2f(p0[r]);
}
__device__ __forceinline__ void finishSM(f32x16& p0, f32x16& p1, float alpha, float& l_reg, f16x8& pa0, f16x8& pa1, f16x8& pa2, f16x8& pa3) {
#pragma unroll
    for (int r = 0; r < 16; ++r) p1[r] = __builtin_amdgcn_exp2f(p1[r]);
    float ps = 0;
#pragma unroll
    for (int r = 0; r < 16; ++r) ps += p0[r];
#pragma unroll
    for (int r = 0; r < 16; ++r) ps += p1[r];
    { auto rr = __builtin_amdgcn_permlane32_swap(__float_as_uint(ps), __float_as_uint(ps), false, false);
      ps = __uint_as_float(rr[0]) + __uint_as_float(rr[1]); }
    l_reg = l_reg * alpha + ps;
#define PK4(P, B_, OUT) do { unsigned a0 = pkh(P[B_+0], P[B_+1]), a1 = pkh(P[B_+2], P[B_+3]);                          \
        unsigned b0 = pkh(P[B_+4], P[B_+5]), b1 = pkh(P[B_+6], P[B_+7]);                                             \
        auto r0 = __builtin_amdgcn_permlane32_swap(a0, b0, false, false); auto r1 = __builtin_amdgcn_permlane32_swap(a1, b1, false, false); \
        u32x4 w = {r0[0], r1[0], r0[1], r1[1]}; OUT = __builtin_bit_cast(f16x8, w); } while (0)
    PK4(p0, 0, pa0); PK4(p0, 8, pa1); PK4(p1, 0, pa2); PK4(p1, 8, pa3);
#undef PK4
}
template <int MODE, int KB>
__device__ __forceinline__ void qkt(f32x16& p0, f32x16& p1, lptr K_lds, int r32, int hi, const f16x8* qr) {
    constexpr int KROWB = Cfg<MODE>::KROWB, NQF = Cfg<MODE>::NQF;
    p0 = f32x16{}; p1 = f32x16{};
    lptr kb[4];
#pragma unroll
    for (int dd = 0; dd < 4; ++dd) kb[dd] = K_lds + KB * SHM_KMAX + r32 * KROWB + (((dd * 16 + hi * 8) * 2) ^ ((r32 & 7) << 4));
#pragma unroll
    for (int d0 = 0; d0 < NQF; ++d0) { lptr a = kb[d0 & 3] + (d0 >> 2) * 128;
        const f16x8 b0 = *(const LAS f16x8*)(a);
        const f16x8 b1 = *(const LAS f16x8*)(a + 32 * KROWB);
        p0 = __builtin_amdgcn_mfma_f32_32x32x16_f16(b0, qr[d0], p0, 0, 0, 0);
        p1 = __builtin_amdgcn_mfma_f32_32x32x16_f16(b1, qr[d0], p1, 0, 0, 0); }
}
template <int MODE, int KB>
__device__ __forceinline__ void qkt2(f32x16& p0, f32x16& p1, const unsigned (&kbv)[8], const f16x8* qr) {
    constexpr int KROWB = Cfg<MODE>::KROWB, NQF = Cfg<MODE>::NQF, NG = NQF / 2, B0 = KB * SHM_KMAX, H = 32 * KROWB;
#define KRD(dst, d0) do { asm volatile("ds_read_b128 %0, %1 offset:%2" : "=&v"(dst[0]) : "v"(kbv[(d0) & 7]), "i"(B0 + ((d0) >> 3) * 256) : "memory");        \
                          asm volatile("ds_read_b128 %0, %1 offset:%2" : "=&v"(dst[1]) : "v"(kbv[(d0) & 7]), "i"(B0 + ((d0) >> 3) * 256 + H) : "memory"); } while (0)
    f16x8 ka[2][2], kb[2][2];
    p0 = f32x16{}; p1 = f32x16{};
    KRD(ka[0], 0); KRD(ka[1], 1); KRD(kb[0], 2); KRD(kb[1], 3);
#pragma unroll
    for (int g = 0; g < NG; ++g) {
        if (g + 1 < NG) asm volatile("s_waitcnt lgkmcnt(4)" ::: "memory"); else asm volatile("s_waitcnt lgkmcnt(0)" ::: "memory");
        SBAR();
        if ((g & 1) == 0) {
            p0 = __builtin_amdgcn_mfma_f32_32x32x16_f16(ka[0][0], qr[2 * g], p0, 0, 0, 0); p1 = __builtin_amdgcn_mfma_f32_32x32x16_f16(ka[0][1], qr[2 * g], p1, 0, 0, 0);
            p0 = __builtin_amdgcn_mfma_f32_32x32x16_f16(ka[1][0], qr[2 * g + 1], p0, 0, 0, 0); p1 = __builtin_amdgcn_mfma_f32_32x32x16_f16(ka[1][1], qr[2 * g + 1], p1, 0, 0, 0);
            SBAR();
            if (g + 2 < NG) { KRD(ka[0], 2 * g + 4); KRD(ka[1], 2 * g + 5); }
        } else {
            p0 = __builtin_amdgcn_mfma_f32_32x32x16_f16(kb[0][0], qr[2 * g], p0, 0, 0, 0); p1 = __builtin_amdgcn_mfma_f32_32x32x16_f16(kb[0][1], qr[2 * g], p1, 0, 0, 0);
            p0 = __builtin_amdgcn_mfma_f32_32x32x16_f16(kb[1][0], qr[2 * g + 1], p0, 0, 0, 0); p1 = __builtin_amdgcn_mfma_f32_32x32x16_f16(kb[1][1], qr[2 * g + 1], p1, 0, 0, 0);
            SBAR();
            if (g + 2 < NG) { KRD(kb[0], 2 * g + 4); KRD(kb[1], 2 * g + 5); }
        }
    }
#undef KRD
}
template <int VB>
__device__ __forceinline__ void pv_tile(f32x16* o, int vb0, f16x8 pa0, f16x8 pa1, f16x8 pa2, f16x8 pa3) {
#define TRRD(dst, off) asm volatile("ds_read_b64_tr_b16 %0, %1 offset:%2" : "=&v"(dst) : "v"(vb0), "i"(off) : "memory")
#define MK8(l, h) __builtin_bit_cast(f16x8, __builtin_shufflevector(l, h, 0, 1, 2, 3, 4, 5, 6, 7))
#define PV_D0(d0) do { s16x4 l0, l1, l2, l3, h0, h1, h2, h3; constexpr int b_ = VB * SHM_V + v_rd_off(d0, 0, 0);   \
        TRRD(l0, b_); TRRD(h0, b_ + 2048); TRRD(l1, b_ + 4096); TRRD(h1, b_ + 6144); TRRD(l2, b_ + 8192); TRRD(h2, b_ + 10240); TRRD(l3, b_ + 12288); TRRD(h3, b_ + 14336); \
        asm volatile("s_waitcnt lgkmcnt(0)" ::: "memory"); SBAR();                                                   \
        o[d0] = __builtin_amdgcn_mfma_f32_32x32x16_f16(pa0, MK8(l0, h0), o[d0], 0, 0, 0);   \
        o[d0] = __builtin_amdgcn_mfma_f32_32x32x16_f16(pa1, MK8(l1, h1), o[d0], 0, 0, 0);   \
        o[d0] = __builtin_amdgcn_mfma_f32_32x32x16_f16(pa2, MK8(l2, h2), o[d0], 0, 0, 0);   \
        o[d0] = __builtin_amdgcn_mfma_f32_32x32x16_f16(pa3, MK8(l3, h3), o[d0], 0, 0, 0); } while (0)
    PV_D0(0); PV_D0(1); PV_D0(2); PV_D0(3);
#undef PV_D0
#undef MK8
#undef TRRD
}

struct BlockRef { const h16* Q; const h16* K; const h16* V; h16* O; const h16* KP; const float* BI; int P0; };
template <int MODE> struct Seam { f16x8 qr[Cfg<MODE>::NQF]; f16x8 st_v0, st_v1, st_k0, st_k1, st_p; float st_b; };

#define VMW() asm volatile("s_waitcnt vmcnt(0)" ::: "memory")
#define VMWN(n) asm volatile("s_waitcnt vmcnt(%0)" :: "i"(n) : "memory")
#define AT_SLOAD(R, k0) do { S.st_v0 = ld8((R).V + (size_t)((k0) + sr) * PV + sc); S.st_v1 = ld8((R).V + (size_t)((k0) + 32 + sr) * PV + sc);              \
                             S.st_k0 = ld8((R).K + (size_t)((k0) + sr) * PK + sc); S.st_k1 = ld8((R).K + (size_t)((k0) + 32 + sr) * PK + sc);              \
                             if constexpr (MODE == 0) S.st_p = ld8((R).KP + (size_t)((k0) + (tid >> 3)) * LATP + (tid & 7) * 8);                         \
                             else S.st_b = (R).BI[(k0) + lane]; } while (0)
#define AT_SWRITE_K(bf) do { *(LAS f16x8*)(K_lds + (bf) * SHM_KMAX + kws) = S.st_k0; *(LAS f16x8*)(K_lds + (bf) * SHM_KMAX + kws + 32 * KROWB) = S.st_k1;     \
                             if constexpr (MODE == 0) *(LAS f16x8*)(K_lds + (bf) * SHM_KMAX + kwp) = S.st_p;                                                \
                             else { if (wid == 0) bias_l[(bf) * 64 + lane] = S.st_b; } } while (0)
#define AT_SWRITE_V(bf) do { *(LAS f16x8*)(V_lds + (bf) * SHM_V + vst0) = S.st_v0; *(LAS f16x8*)(V_lds + (bf) * SHM_V + vst1) = S.st_v1; } while (0)
#define AT_SWRITE(bf) do { AT_SWRITE_V(bf); AT_SWRITE_K(bf); } while (0)

template <int MODE>
__device__ __forceinline__ void attn_prime(const BlockRef& cur, lptr lds, Seam<MODE>& S) {
    constexpr int KROWB = Cfg<MODE>::KROWB, NQF = Cfg<MODE>::NQF, PQ = Cfg<MODE>::PQ, PK = Cfg<MODE>::PK, PV = Cfg<MODE>::PV;
    const int tid = opq_v((int)threadIdx.x), wid = __builtin_amdgcn_readfirstlane(tid >> 6), lane = tid & 63, r32 = lane & 31, hi = lane >> 5;
    const int sr = tid >> 4, sc = (tid & 15) * 8;
    const int kws = sr * KROWB + ((sc * 2) ^ ((sr & 7) << 4));
    const int kwp = (tid >> 3) * KROWB + ((256 + (tid & 7) * 16) ^ (((tid >> 3) & 7) << 4));
    lptr K_lds = lds + OFF_K; LAS float* bias_l = (LAS float*)(lds + OFF_BIAS);
    (void)kwp; (void)bias_l;
#pragma unroll
    for (int d0 = 0; d0 < NQF; ++d0) S.qr[d0] = ld8(cur.Q + (size_t)(wid * QBLK + r32) * PQ + d0 * 16 + hi * 8);
    AT_SLOAD(cur, 0); VMW(); AT_SWRITE_K(0);
    __syncthreads();
}
template <int MODE>
__device__ __forceinline__ void attn_block(const BlockRef& cur, const BlockRef& nxt, lptr lds, Seam<MODE>& S) {
    constexpr int KROWB = Cfg<MODE>::KROWB, NQF = Cfg<MODE>::NQF, PQ = Cfg<MODE>::PQ, PK = Cfg<MODE>::PK, PV = Cfg<MODE>::PV;
    const int tid = opq_v((int)threadIdx.x), wid = __builtin_amdgcn_readfirstlane(tid >> 6), lane = tid & 63, r32 = lane & 31, hi = lane >> 5;
    const int NT = cur.P0 / KVBLK + QB / KVBLK;
    const int qlo = cur.P0 + wid * QBLK;
    const int qeff = (MODE == 0) ? (qlo | 63) : qlo;
    const int qm = ((MODE == 0) ? (qlo | 63) : (qlo + r32)) - 4 * hi;
    lptr V_lds = lds + OFF_V; lptr K_lds = lds + OFF_K;
    LAS float* ws = (LAS float*)(lds + OFF_WS) + wid * 64; LAS float* li_l = ws; LAS float* al_l = ws + 32;
    LAS float* bias_l = (LAS float*)(lds + OFF_BIAS);
    float m_reg = -1e30f, l_reg = 0; f32x16 o[4] = {};
    const int sr = tid >> 4, sc = (tid & 15) * 8, vst0 = v_st(sr, sc), vst1 = v_st(32 + sr, sc);
    const int kws = sr * KROWB + ((sc * 2) ^ ((sr & 7) << 4));
    const int kwp = (tid >> 3) * KROWB + ((256 + (tid & 7) * 16) ^ (((tid >> 3) & 7) << 4));
    (void)kwp; (void)bias_l;
    const int vb0 = (int)(unsigned)(uintptr_t)V_lds + v_rd_base(lane);
#define RESC(a) do { if (__any((a) < 1.f)) { if (hi == 0) al_l[r32] = (a); asm volatile("s_waitcnt lgkmcnt(0)" ::: "memory");              \
                     _Pragma("unroll") for (int d_ = 0; d_ < 4; ++d_) _Pragma("unroll") for (int r = 0; r < 16; ++r) o[d_][r] *= al_l[crow(r, hi)]; } } while (0)
#define KBASE(t) ((t) * KVBLK)
#define BIASADD(P0_, P1_, KBUF) do { if constexpr (MODE == 1) { constexpr float C2 = LOG2E * Cfg<1>::SCALE; const LAS float* bb = bias_l + (KBUF) * 64 + 4 * hi;   \
        _Pragma("unroll") for (int g_ = 0; g_ < 4; ++g_) { const f32x4 ba = *(const LAS f32x4*)(bb + 8 * g_), bc = *(const LAS f32x4*)(bb + 32 + 8 * g_);          \
            _Pragma("unroll") for (int e_ = 0; e_ < 4; ++e_) { P0_[4 * g_ + e_] = fmaf(P0_[4 * g_ + e_], C2, ba[e_]); P1_[4 * g_ + e_] = fmaf(P1_[4 * g_ + e_], C2, bc[e_]); } } } } while (0)
#define MASKT(P0_, P1_, t) do { const int kb_ = KBASE(t); if (kb_ + KVBLK - 1 > qeff) mask_tile(P0_, P1_, qm - kb_); } while (0)
#define SEAM_K0() do { VMWN(NQF); AT_SWRITE_K(0); SBAR(); } while (0)
    f32x16 pA0, pA1, pB0, pB1; float mnA, mnB, alA, alB; f16x8 pa0, pa1, pa2, pa3;
    AT_SWRITE_V(0); SBAR();
    AT_SLOAD(cur, KBASE(1));
    SBAR(); qkt<MODE, 0>(pA0, pA1, K_lds, r32, hi, S.qr);
    BIASADD(pA0, pA1, 0); MASKT(pA0, pA1, 0); partialSM<MODE>(pA0, pA1, m_reg, mnA, alA);
    VMW(); AT_SWRITE(1);
    __syncthreads();
#define HALF_STEP(PX0, PX1, mnX, alX, PY0, PY1, alY, t, KB, VB, SB) do {                                                      \
        SBAR(); qkt<MODE, KB>(PX0, PX1, K_lds, r32, hi, S.qr);                                                                \
        finishSM(PY0, PY1, alY, l_reg, pa0, pa1, pa2, pa3); SBAR();                                                           \
        if ((t) + 1 < NT) { AT_SLOAD(cur, KBASE((t) + 1)); SBAR(); }                                                          \
        pv_tile<VB>(o, vb0, pa0, pa1, pa2, pa3); BIASADD(PX0, PX1, KB); MASKT(PX0, PX1, (t)); partialSM<MODE>(PX0, PX1, m_reg, mnX, alX);   \
        __syncthreads();                                                                                                      \
        if ((t) + 1 < NT) { VMW(); AT_SWRITE(SB); }                                                                           \
        RESC(alX); __syncthreads(); } while (0)
    for (int t = 1; t + 1 < NT; t += 2) {
        HALF_STEP(pB0, pB1, mnB, alB, pA0, pA1, alA, t, 1, 0, 0);
        HALF_STEP(pA0, pA1, mnA, alA, pB0, pB1, alB, t + 1, 0, 1, 1);
    }
    SBAR(); qkt<MODE, 1>(pB0, pB1, K_lds, r32, hi, S.qr); SBAR();
    AT_SLOAD(nxt, 0); SBAR();
#pragma unroll
    for (int d0 = 0; d0 < NQF; ++d0) S.qr[d0] = ld8(nxt.Q + (size_t)(wid * QBLK + r32) * PQ + d0 * 16 + hi * 8);
    SBAR();
    finishSM(pA0, pA1, alA, l_reg, pa0, pa1, pa2, pa3); SBAR();
    pv_tile<0>(o, vb0, pa0, pa1, pa2, pa3);
    BIASADD(pB0, pB1, 1); MASKT(pB0, pB1, NT - 1); partialSM<MODE>(pB0, pB1, m_reg, mnB, alB); __syncthreads(); RESC(alB);
    finishSM(pB0, pB1, alB, l_reg, pa0, pa1, pa2, pa3); SBAR(); pv_tile<1>(o, vb0, pa0, pa1, pa2, pa3);
    SBAR(); SEAM_K0();
    if (hi == 0) li_l[r32] = l_reg; asm volatile("s_waitcnt lgkmcnt(0)" ::: "memory");
    float rli[16];
#pragma unroll
    for (int r = 0; r < 16; ++r) rli[r] = __builtin_amdgcn_rcpf(li_l[crow(r, hi)]);
    h16* Ow = cur.O + (size_t)(wid * QBLK) * D;
#pragma unroll
    for (int r = 0; r < 16; ++r) { const int orow = crow(r, hi);
#pragma unroll
        for (int d0 = 0; d0 < 4; ++d0) { const float v = o[d0][r] * rli[r];
            const float vn = __shfl_xor(v, 1);
            if ((r32 & 1) == 0) *(unsigned*)(Ow + (size_t)orow * D + d0 * 32 + r32) = pkh(v, vn); } }
    __syncthreads();
#undef RESC
#undef KBASE
#undef BIASADD
#undef MASKT
#undef SEAM_K0
#undef HALF_STEP
}
template <int MODE>
__device__ __forceinline__ void attn_block_s(const BlockRef& cur, lptr lds) {
    constexpr int KROWB = Cfg<MODE>::KROWB, NQF = Cfg<MODE>::NQF, PQ = Cfg<MODE>::PQ, PK = Cfg<MODE>::PK, PV = Cfg<MODE>::PV;
    const int tid = opq_v((int)threadIdx.x), wid = __builtin_amdgcn_readfirstlane(tid >> 6), lane = tid & 63, r32 = lane & 31, hi = lane >> 5;
    const int NT = cur.P0 / KVBLK + QB / KVBLK;
    const int qlo = cur.P0 + wid * QBLK;
    const int qeff = (MODE == 0) ? (qlo | 63) : qlo;
    const int qm = ((MODE == 0) ? (qlo | 63) : (qlo + r32)) - 4 * hi;
    lptr V_lds = lds + OFF_V; lptr K_lds = lds + OFF_K;
    LAS float* ws = (LAS float*)(lds + OFF_WS) + wid * 64; LAS float* li_l = ws; LAS float* al_l = ws + 32;
    LAS float* bias_l = (LAS float*)(lds + OFF_BIAS);
    float m_reg = -1e30f, l_reg = 0; f32x16 o[4] = {};
    const int sr = tid >> 4, sc = (tid & 15) * 8, vst0 = v_st(sr, sc), vst1 = v_st(32 + sr, sc);
    const int kws = sr * KROWB + ((sc * 2) ^ ((sr & 15) << 4));
    const int kwp = (tid >> 3) * KROWB + 256 + (((tid & 7) * 16) ^ (((tid >> 3) & 15) << 4));
    (void)kwp; (void)bias_l;
    const int vb0 = (int)(unsigned)(uintptr_t)V_lds + v_rd_base(lane);
    unsigned kbv[8];
#pragma unroll
    for (int dd = 0; dd < 8; ++dd) kbv[dd] = (unsigned)(uintptr_t)K_lds + r32 * KROWB + (((dd * 16 + hi * 8) * 2) ^ ((r32 & 15) << 4));
    Seam<MODE> S;
#pragma unroll
    for (int d0 = 0; d0 < NQF; ++d0) S.qr[d0] = ld8(cur.Q + (size_t)(wid * QBLK + r32) * PQ + d0 * 16 + hi * 8);
    AT_SLOAD(cur, 0); VMW(); AT_SWRITE(0); SBAR();
    AT_SLOAD(cur, KVBLK);
    __syncthreads();
    f32x16 p0, p1; float mn, al; f16x8 pa0, pa1, pa2, pa3;
#define RESC(a) do { if (__any((a) < 1.f)) { if (hi == 0) al_l[r32] = (a); asm volatile("s_waitcnt lgkmcnt(0)" ::: "memory");              \
                     _Pragma("unroll") for (int d_ = 0; d_ < 4; ++d_) _Pragma("unroll") for (int r = 0; r < 16; ++r) o[d_][r] *= al_l[crow(r, hi)]; } } while (0)
#define BIASADD(P0_, P1_, KBUF) do { if constexpr (MODE == 1) { constexpr float C2 = LOG2E * Cfg<1>::SCALE; const LAS float* bb = bias_l + (KBUF) * 64 + 4 * hi;   \
        _Pragma("unroll") for (int g_ = 0; g_ < 4; ++g_) { const f32x4 ba = *(const LAS f32x4*)(bb + 8 * g_), bc = *(const LAS f32x4*)(bb + 32 + 8 * g_);          \
            _Pragma("unroll") for (int e_ = 0; e_ < 4; ++e_) { P0_[4 * g_ + e_] = fmaf(P0_[4 * g_ + e_], C2, ba[e_]); P1_[4 * g_ + e_] = fmaf(P1_[4 * g_ + e_], C2, bc[e_]); } } } } while (0)
#define STEP(t, BUF) do { SBAR(); qkt2<MODE, BUF>(p0, p1, kbv, S.qr);                                                \
        BIASADD(p0, p1, BUF); { const int kb_ = (t) * KVBLK; if (kb_ + KVBLK - 1 > qeff) mask_tile(p0, p1, qm - kb_); }           \
        partialSM<MODE>(p0, p1, m_reg, mn, al); finishSM(p0, p1, al, l_reg, pa0, pa1, pa2, pa3); RESC(al); SBAR();              \
        pv_tile<BUF>(o, vb0, pa0, pa1, pa2, pa3); SBAR();                                                                      \
        if ((t) + 1 < NT) { VMW(); AT_SWRITE((BUF) ^ 1); SBAR(); if ((t) + 2 < NT) AT_SLOAD(cur, ((t) + 2) * KVBLK); }            \
        __syncthreads(); } while (0)
    for (int t = 0; t < NT; t += 2) { STEP(t, 0); STEP(t + 1, 1); }
#undef STEP
#undef BIASADD
#undef RESC
    if (hi == 0) li_l[r32] = l_reg; asm volatile("s_waitcnt lgkmcnt(0)" ::: "memory");
    LAS h16* ost = (LAS h16*)(lds + wid * 8192);
#pragma unroll
    for (int r = 0; r < 16; ++r) { const float rl = __builtin_amdgcn_rcpf(li_l[crow(r, hi)]); const int orow = crow(r, hi);
#pragma unroll
        for (int d0 = 0; d0 < 4; ++d0) ost[orow * 128 + d0 * 32 + r32] = (h16)(o[d0][r] * rl); }
    asm volatile("s_waitcnt lgkmcnt(0)" ::: "memory");
    h16* Ow = cur.O + (size_t)(wid * QBLK) * D;
#pragma unroll
    for (int i = 0; i < 8; ++i) { const int row = (lane >> 4) + 4 * i, ch = lane & 15;
        *(u32x4*)(Ow + (size_t)row * D + ch * 8) = *(const LAS u32x4*)(ost + row * 128 + ch * 8); }
    __syncthreads();
}
#undef AT_SLOAD
#undef AT_SWRITE_K
#undef AT_SWRITE_V
#undef AT_SWRITE
#undef VMW
#undef VMWN

template <int MODE>
__device__ __forceinline__ BlockRef make_ref(int L, int pass, const h16* Qb, const h16* Kb, const h16* Vb, h16* Ob, const h16* KPb, const float* BIb) {
    constexpr int PQ = Cfg<MODE>::PQ, PK = Cfg<MODE>::PK, PV = Cfg<MODE>::PV, HD = (MODE == 0) ? QKD : 128;
    const int bh = L >> 2, x = L & 3, qb = pass ? (7 - x) : x, b = bh >> 4, h = bh & 15;
    BlockRef r;
    r.Q = Qb + ((size_t)b * SEQ + (size_t)qb * QB) * PQ + h * HD;
    r.K = Kb + (size_t)b * SEQ * PK + h * 128;
    r.V = Vb + (size_t)b * SEQ * PV + h * 128;
    r.O = Ob + ((size_t)b * SEQ + (size_t)qb * QB) * D + h * 128;
    r.KP = KPb + (size_t)b * SEQ * LATP;
    r.BI = BIb + (size_t)bh * SEQ;
    r.P0 = qb * QB;
    return r;
}
template <int MODE, bool PIPE>
__device__ __forceinline__ void attn_phase(lptr lds, int first, int stride, const h16* Qb, const h16* Kb, const h16* Vb, h16* Ob, const h16* KPb, const float* BIb) {
    constexpr int total = BATCH * NHEAD * 4;
    int L = first; if (L >= total) return;
    if constexpr (PIPE) {
        int pass = 0;
        BlockRef cur = make_ref<MODE>(L, 0, Qb, Kb, Vb, Ob, KPb, BIb);
        Seam<MODE> S;
        attn_prime<MODE>(cur, lds, S);
        for (;;) {
            const bool more_pass = pass == 0, more_item = L + stride < total, last = !more_pass && !more_item;
            int passn = pass + 1, Ln = L;
            if (!more_pass) { passn = 0; Ln = more_item ? L + stride : L; }
            const BlockRef nxt = last ? cur : make_ref<MODE>(Ln, passn, Qb, Kb, Vb, Ob, KPb, BIb);
            attn_block<MODE>(cur, nxt, lds, S);
            if (last) break;
            cur = nxt; pass = passn; L = Ln;
        }
    } else {
        for (; L < total; L += stride)
            for (int pass = 0; pass < 2; ++pass) { const BlockRef cur = make_ref<MODE>(L, pass, Qb, Kb, Vb, Ob, KPb, BIb); attn_block_s<MODE>(cur, lds); }
    }
}
}

typedef GAS unsigned gu32;
#define RLX_AGENT __ATOMIC_RELAXED, __HIP_MEMORY_SCOPE_AGENT
#define XB_TMO      128
#define XB_XCNT(j)  (256  + 64 * (j))
#define XB_XSUB(j)  (1280 + 64 * (j))
#define XB_XGEN(j)  (2304 + 64 * (j))
#define XB_TOP      3328
#define XB_TOPGEN   3392
#define XCD_BAR_WORDS 3456
#define XB_SPIN_CAP (1u << 18)
__device__ __forceinline__ unsigned xb_ld(unsigned* p)              { return __hip_atomic_load(p, __ATOMIC_RELAXED, __HIP_MEMORY_SCOPE_AGENT); }
__device__ __forceinline__ unsigned xb_add(unsigned* p, unsigned v) { return __hip_atomic_fetch_add(p, v, __ATOMIC_RELAXED, __HIP_MEMORY_SCOPE_AGENT); }
__device__ __forceinline__ unsigned xb_xcc_id() { return (unsigned)__builtin_amdgcn_s_getreg((3 << 11) | 20) & 0xFu; }
#define XB_SPIN(cond, bar) do { unsigned _sp = 0; while (cond) { __builtin_amdgcn_s_sleep(1); \
    if ((++_sp & 255u) == 0u) { if (xb_ld(&(bar)[XB_TMO])) break; if (_sp > XB_SPIN_CAP) { atomicAdd(&(bar)[XB_TMO], 1u); break; } } } } while (0)
struct XcdBarrier { unsigned* bar; unsigned x; volatile LAS unsigned* st; };
__device__ __forceinline__ XcdBarrier xcd_barrier_post(unsigned* bar, volatile LAS unsigned* st) {
    XcdBarrier b; b.bar = bar; b.x = xb_xcc_id(); b.st = st;
    if (threadIdx.x == 0) (void)xb_add(&bar[XB_XCNT(b.x)], 1u);
    return b;
}
__device__ __forceinline__ void xcd_barrier_complete(unsigned* bar, unsigned x, unsigned& nloc, unsigned& nx) {
    const unsigned G = gridDim.x * gridDim.y * gridDim.z;
    unsigned sum, cnt, mine, sp = 0u;
    for (;;) {
        sum = 0u; cnt = 0u; mine = 0u;
#pragma unroll
        for (unsigned j = 0; j < 16; ++j) { const unsigned c = xb_ld(&bar[XB_XCNT(j)]); sum += c; cnt += (c > 0u) ? 1u : 0u; mine = (j == x) ? c : mine; }
        if (sum == G) break;
        __builtin_amdgcn_s_sleep(1);
        if ((++sp & 255u) == 0u) { if (xb_ld(&bar[XB_TMO])) break; if (sp > XB_SPIN_CAP) { atomicAdd(&bar[XB_TMO], 1u); break; } }
    }
    nloc = mine > 0u ? mine : 1u; nx = cnt > 0u ? cnt : 1u;
}
__device__ __forceinline__ void xcd_barrier(const XcdBarrier& b) {
    asm volatile("s_waitcnt vmcnt(0)" ::: "memory");
    __syncthreads();
    if (threadIdx.x == 0) {
        unsigned* bar = b.bar;
        __builtin_amdgcn_s_waitcnt(0);
        unsigned nloc = b.st[0], nx = b.st[1];
        if (nloc == 0u) { xcd_barrier_complete(bar, b.x, nloc, nx); b.st[0] = nloc; b.st[1] = nx; }
        const unsigned old = xb_add(&bar[XB_XSUB(b.x)], 1u);
        const unsigned gen = old / nloc;
        if (old + 1u == (gen + 1u) * nloc) {
            __builtin_amdgcn_fence(__ATOMIC_RELEASE, "agent");
            asm volatile("s_waitcnt vmcnt(0)" ::: "memory");
            const unsigned og = xb_add(&bar[XB_TOP], 1u);
            const unsigned tg = og / nx;
            if (og + 1u == (tg + 1u) * nx) xb_add(&bar[XB_TOPGEN], 1u);
            else XB_SPIN(xb_ld(&bar[XB_TOPGEN]) == tg, bar);
            __builtin_amdgcn_fence(__ATOMIC_ACQUIRE, "agent");
            xb_add(&bar[XB_XGEN(b.x)], 1u);
            asm volatile("s_waitcnt vmcnt(0)" ::: "memory");
        } else {
            XB_SPIN(xb_ld(&bar[XB_XGEN(b.x)]) == gen, bar);
            __builtin_amdgcn_fence(__ATOMIC_ACQUIRE, "agent");
            asm volatile("s_waitcnt vmcnt(0)" ::: "memory");
        }
    }
    __syncthreads();
}

__device__ __forceinline__ float wave_sum(float v) {
#pragma unroll
    for (int o = 1; o < 64; o <<= 1) v += __shfl_xor(v, o);
    return v;
}
constexpr int CVT_SCR = 128 * 33 * 4;
__device__ __forceinline__ void cvt_item(const float* W, int K, int N, h16* WT, int rowmode, const float* kscale, LAS float* scr, int item, int lane) {
    const int nblk = (N + 31) / 32, kb = item / nblk, nb = item % nblk, k0 = 128 * kb, n0 = 32 * nb;
    const bool nok = (n0 + (lane & 31)) < N;
    const float* src = W + (size_t)(k0 + (lane >> 5)) * N + n0 + (lane & 31);
    float r[64];
#pragma unroll
    for (int i = 0; i < 64; ++i) r[i] = nok ? src[(size_t)(2 * i) * N] : 0.f;
#pragma unroll
    for (int i = 0; i < 64; ++i) scr[(2 * i + (lane >> 5)) * 33 + (lane & 31)] = r[i];
    LDS_WAIT(); asm volatile("" ::: "memory");
    const int c = lane & 15;
    const int drow0 = rowmode >= 0 ? rowmode + n0 : 256 * (n0 >> 7) + (rowmode == -2 ? 128 : 0) + (n0 & 127);
    f32x4 s0 = (f32x4){1.f, 1.f, 1.f, 1.f}, s1 = s0;
    if (kscale) { s0 = *(const f32x4*)(kscale + k0 + 8 * c); s1 = *(const f32x4*)(kscale + k0 + 8 * c + 4); }
#pragma unroll
    for (int j = 0; j < 8; ++j) { const int n = (lane >> 4) + 4 * j; const LAS float* s = scr + (8 * c) * 33 + n;
        u32x4 o; o.x = pkh(s[0 * 33] * s0[0], s[1 * 33] * s0[1]); o.y = pkh(s[2 * 33] * s0[2], s[3 * 33] * s0[3]); o.z = pkh(s[4 * 33] * s1[0], s[5 * 33] * s1[1]); o.w = pkh(s[6 * 33] * s1[2], s[7 * 33] * s1[3]);
        *(u32x4*)(WT + (size_t)(drow0 + n) * K + k0 + 8 * c) = o; }
    LDS_WAIT(); asm volatile("" ::: "memory");
}

__device__ __forceinline__ void fgate_rows(LAS unsigned char* lds, const h16* Hb, const h16* WfT, const float* bf, float* LOGF, int row0) {
    const int tid = opq_v((int)threadIdx.x), lane = tid & 63, wave = __builtin_amdgcn_readfirstlane(tid >> 6), fr = lane & 15, fq = lane >> 4;
    f32x4 acc0 = {0.f, 0.f, 0.f, 0.f}, acc1 = acc0;
    const h16* a0 = Hb + (size_t)(row0 + fr) * D + wave * 256 + 8 * fq; const h16* a1 = a0 + (size_t)16 * D;
    const h16* bp = WfT + (size_t)fr * D + wave * 256 + 8 * fq;
#pragma unroll
    for (int ks = 0; ks < 8; ++ks) { const f16x8 b = *(const f16x8*)(bp + 32 * ks), x0 = *(const f16x8*)(a0 + 32 * ks), x1 = *(const f16x8*)(a1 + 32 * ks);
        acc0 = __builtin_amdgcn_mfma_f32_16x16x32_f16(b, x0, acc0, 0, 0, 0); acc1 = __builtin_amdgcn_mfma_f32_16x16x32_f16(b, x1, acc1, 0, 0, 0); }
    LAS float* red = (LAS float*)lds;
    *(LAS f32x4*)(red + wave * 512 + fr * 16 + 4 * fq) = acc0; *(LAS f32x4*)(red + wave * 512 + (16 + fr) * 16 + 4 * fq) = acc1;
    __syncthreads();
    { float z = bf[tid & 15];
#pragma unroll
      for (int w = 0; w < 8; ++w) z += red[w * 512 + tid];
      LOGF[(size_t)(row0 + (tid >> 4)) * 16 + (tid & 15)] = fminf(z, 0.f) - log1pf(expf(-fabsf(z))); }
    __syncthreads();
}

struct Args {
    const float* x; const float* c; const int* pos; const float* ada_w; const float* ada_b;
    const float* ln1_g; const float* ln1_b; const float* ln2_g; const float* ln2_b;
    const float* w1; const float* w3; const float* w2;
    const float* w_down; const float* q_norm; const float* w_uq; const float* kv_norm; const float* w_uk; const float* w_uv; const float* mla_wo;
    const float* fox_win; const float* fox_bf; const float* fox_wo;
    float* out; unsigned char* ws; int ph_lo, ph_hi;
};

__device__ __forceinline__ void ln_phase(int gw, int NGW, int lane, const h16* V, float* Xo, float* ST, h16* Ho, const float* g, const float* bt, const float* modl, int sc_idx, int sh_idx) {
    for (int m = gw; m < M; m += NGW) {
        const f16x8* vr = (const f16x8*)(V + (size_t)m * D) + lane;
        float v[32]; float s = 0.f;
#pragma unroll
        for (int j = 0; j < 4; ++j) { const f16x8 t = vr[64 * j];
#pragma unroll
            for (int e = 0; e < 8; ++e) { v[8 * j + e] = (float)t[e]; s += v[8 * j + e]; } }
        const float mean = wave_sum(s) * (1.f / D); float s2 = 0.f;
#pragma unroll
        for (int i = 0; i < 32; ++i) { v[i] -= mean; s2 += v[i] * v[i]; }
        const float rstd = 1.f / sqrtf(wave_sum(s2) * (1.f / D) + LN_EPS);
        if (ST && lane == 0) { f32x2 ms = {mean, rstd}; *(f32x2*)(ST + (size_t)m * 2) = ms; }
        const int b = m >> 11;
#pragma unroll
        for (int j = 0; j < 4; ++j) { const int col = 8 * lane + 512 * j;
            const f32x4 g0 = *(const f32x4*)(g + col), g1 = *(const f32x4*)(g + col + 4), b0 = *(const f32x4*)(bt + col), b1 = *(const f32x4*)(bt + col + 4);
            f32x4 y0, y1;
#pragma unroll
            for (int e = 0; e < 4; ++e) { y0[e] = v[8 * j + e] * rstd * g0[e] + b0[e]; y1[e] = v[8 * j + 4 + e] * rstd * g1[e] + b1[e]; }
            if (Xo) { *(f32x4*)(Xo + (size_t)m * D + col) = y0; *(f32x4*)(Xo + (size_t)m * D + col + 4) = y1; }
            if (Ho) { const float* scp = modl + (size_t)b * MODW + sc_idx * D + col; const float* shp = modl + (size_t)b * MODW + sh_idx * D + col;
                const f32x4 h0 = y0 * (*(const f32x4*)scp + 1.0f) + *(const f32x4*)shp, h1 = y1 * (*(const f32x4*)(scp + 4) + 1.0f) + *(const f32x4*)(shp + 4);
                *(u32x4*)(Ho + (size_t)m * D + col) = pk8(h0, h1); } }
    }
}

constexpr int NPHASE = 3 + 8 * NLAYER;

__global__ void __launch_bounds__(NWAVES * 64, 2) trunk_fwd(Args args) {
    extern __shared__ __attribute__((aligned(16))) unsigned char lds_raw[];
    LAS unsigned char* lds = (LAS unsigned char*)lds_raw;
    volatile LAS unsigned* MISC = (volatile LAS unsigned*)(lds + MISC_OFF);
    const int G = gridDim.x; const int bx = blockIdx.x; const int vcu = (G % 8 == 0) ? (bx % 8) * (G / 8) + bx / 8 : bx;
    const int NGW = G * NWAVES;
#define SITE_IDS() const int tid = opq_v((int)threadIdx.x), lane = tid & 63, wave = __builtin_amdgcn_readfirstlane(tid >> 6), gw = vcu * NWAVES + wave; (void)lane; (void)gw
    unsigned char* ws = args.ws;
    unsigned* ctl = (unsigned*)(ws + WS_CTL);
    float* MOD = (float*)(ws + WS_MOD); float* SSP = (float*)(ws + WS_SSP); float* LOGF = (float*)(ws + WS_LOGF); float* BIAS = (float*)(ws + WS_BIAS);
    float* STATS = (float*)(ws + WS_STATS); float* ROPE = (float*)(ws + WS_ROPE); float* MODP = (float*)(ws + WS_MODP); h16* X = (h16*)(ws + WS_X);
    h16* Hb = (h16*)(ws + WS_H); h16* LAT = (h16*)(ws + WS_LAT); h16* Ob = (h16*)(ws + WS_O); h16* QKV = (h16*)(ws + WS_QKV); h16* HH = (h16*)(ws + WS_HH); h16* Wb = (h16*)(ws + WS_W);
    for (int u = threadIdx.x; u < (LDS_BYTES - LDSCTL_OFF) / 4; u += NWAVES * 64) ((LAS unsigned*)(lds + LDSCTL_OFF))[u] = 0u;
    __syncthreads();
    XcdBarrier bar; bar.bar = ctl + CW_BAR; bar.x = 0; bar.st = nullptr;
    if (!MK_PER_PHASE) bar = xcd_barrier_post(ctl + CW_BAR, MISC + 8);
    const int lo = args.ph_lo, hi = args.ph_hi;
#define IN(k) (lo <= (k) && (k) < hi)
#define NREP(K) ((PROBE_DUP == (K)) ? 2 : 1)
#define REP_FOR(K) _Pragma("unroll") for (int rep = 0; rep < NREP(K); ++rep)
#define REP_DUMMY(K) (NREP(K) == 2 && rep == 0)
#define REP_BAR(K) do { if (rep + 1 < NREP(K)) xcd_barrier(bar); } while (0)
    float* DUMX = (float*)(ws + WS_DUMX); h16* DUMH = (h16*)(ws + WS_DUMH); (void)DUMX; (void)DUMH;
#define SEAM(k) do { if (IN((k) + 1)) { if (MK_PER_PHASE) { } else xcd_barrier(bar); } } while (0)

    if (IN(0)) {
        REP_FOR(1) {
        SITE_IDS();
        LAS float* scr = (LAS float*)(lds + wave * CVT_SCR);
        int off = 0;
        for (int job = 0; job < 26; ++job) {
            int kind, idx; if (job < 14) { kind = job % 7; idx = job / 7; } else { kind = 7 + (job - 14) % 3; idx = (job - 14) / 3; }
            const float* src; int K, N, rowmode = 0; h16* dst; const float* ks = nullptr;
            h16* mla = Wb + W_MLA0 + (size_t)idx * W_MLA_SZ; h16* fox = Wb + W_FOX0 + (size_t)idx * W_FOX_SZ; h16* ffn = Wb + W_FFN0 + (size_t)idx * W_FFN_SZ;
            switch (kind) {
                case 0: src = args.w_down + (size_t)idx * D * LATN; K = D; N = LATN; dst = mla; break;
                case 1: src = args.w_uq + (size_t)idx * QL * QN; K = QL; N = QN; dst = mla + W_DOWN_SZ; ks = args.q_norm + idx * QL; break;
                case 2: src = args.w_uk + (size_t)idx * KVL * (NHEAD * NOPE); K = KVL; N = NHEAD * NOPE; dst = mla + W_DOWN_SZ; rowmode = QN; ks = args.kv_norm + idx * KVL; break;
                case 3: src = args.w_uv + (size_t)idx * KVL * (NHEAD * VD); K = KVL; N = NHEAD * VD; dst = mla + W_DOWN_SZ; rowmode = QN + NHEAD * NOPE; ks = args.kv_norm + idx * KVL; break;
                case 4: src = args.mla_wo + (size_t)idx * D * D; K = D; N = D; dst = mla + W_DOWN_SZ + W_UP_SZ; break;
                case 5: src = args.fox_win + (size_t)idx * D * PROJN; K = D; N = PROJN; dst = fox; break;
                case 6: src = args.fox_wo + (size_t)idx * D * D; K = D; N = D; dst = fox + W_IN_SZ; break;
                case 7: src = args.w1 + (size_t)idx * D * FF; K = D; N = FF; dst = ffn; rowmode = -1; break;
                case 8: src = args.w3 + (size_t)idx * D * FF; K = D; N = FF; dst = ffn; rowmode = -2; break;
                default: src = args.w2 + (size_t)idx * FF * D; K = FF; N = D; dst = ffn + W_13_SZ; break;
            }
            const int nitems = (K / 128) * ((N + 31) / 32);
            int first = gw - off; if (first < 0) first += NGW;
            for (int it = first; it < nitems; it += NGW) cvt_item(src, K, N, dst, rowmode, ks, scr, it, lane);
            off = (off + nitems) % NGW;
        }
        {
            const int gt = vcu * (NWAVES * 64) + tid, NT = G * NWAVES * 64;
            constexpr int ZD = (LATP - LATN) * D / 8, ZI = (PROJNP - 6176) * D / 8;
            for (int i = gt; i < 2 * (ZD + ZI); i += NT) {
                const int j = i / (ZD + ZI), r = i % (ZD + ZI);
                h16* p = (r < ZD) ? Wb + W_MLA0 + (size_t)j * W_MLA_SZ + (size_t)LATN * D + (size_t)r * 8
                                  : Wb + W_FOX0 + (size_t)j * W_FOX_SZ + (size_t)6176 * D + (size_t)(r - ZD) * 8;
                *(u32x4*)p = (u32x4){0u, 0u, 0u, 0u};
            }
        }
        __syncthreads();
        {
            LAS float* cact = (LAS float*)lds;
            LAS f32x4* red = (LAS f32x4*)(lds + 4096);
            for (int u = vcu; u < NLAYER * 12 * 16; u += G) {
                const int l = u / 192, r = u % 192, cb = r / 16, kc = r % 16;
                { const int b = tid >> 7, kk = tid & 127; const float cv = args.c[b * D + kc * 128 + kk]; cact[b * 128 + kk] = cv / (1.0f + __expf(-cv)); }
                __syncthreads();
                const int cg = tid & 255, ks = tid >> 8;
                const float* wp = args.ada_w + ((size_t)l * D + kc * 128 + ks * 64) * MODW + cb * 1024 + 4 * cg;
                f32x4 a0 = {0.f, 0.f, 0.f, 0.f}, a1 = a0, a2 = a0, a3 = a0;
#pragma unroll 8
                for (int kk = 0; kk < 64; ++kk) { const f32x4 w = *(const f32x4*)(wp + (size_t)kk * MODW); const int ki = ks * 64 + kk;
                    a0 += w * cact[ki]; a1 += w * cact[128 + ki]; a2 += w * cact[256 + ki]; a3 += w * cact[384 + ki]; }
                if (ks == 1) { red[cg * 4 + 0] = a0; red[cg * 4 + 1] = a1; red[cg * 4 + 2] = a2; red[cg * 4 + 3] = a3; }
                __syncthreads();
                if (ks == 0) { a0 += red[cg * 4 + 0]; a1 += red[cg * 4 + 1]; a2 += red[cg * 4 + 2]; a3 += red[cg * 4 + 3];
                    float* op = MODP + (((size_t)kc * NLAYER + l) * BATCH) * MODW + cb * 1024 + 4 * cg;
                    *(f32x4*)(op) = a0; *(f32x4*)(op + MODW) = a1; *(f32x4*)(op + 2 * MODW) = a2; *(f32x4*)(op + 3 * MODW) = a3; }
                __syncthreads();
            }
        }
        {
            LAS float* invf = (LAS float*)(lds + 65536);
            if (tid < 32) invf[tid] = (float)exp(-(double)tid * (9.210340371976184 / 32.0));
            __syncthreads();
            const int gt = vcu * (NWAVES * 64) + tid, NT = G * NWAVES * 64;
            for (int e = gt; e < M * 32; e += NT) { const int m = e >> 5, i = e & 31;
                const float ang = (float)args.pos[m] * invf[i];
                const double rev = (double)ang * 0.15915494309189535; const float fr = (float)(rev - rint(rev));
                f32x2 cs; cs[0] = __builtin_amdgcn_cosf(fr); cs[1] = __builtin_amdgcn_sinf(fr);
                *(f32x2*)(ROPE + (size_t)e * 2) = cs; }
            __syncthreads();
        }
        REP_BAR(1); }
        SEAM(0);
    }
    if (IN(1)) {
        SITE_IDS();
        const int gt = vcu * (NWAVES * 64) + tid, NT = G * NWAVES * 64;
        for (int e = gt; e < NLAYER * BATCH * MODW; e += NT) { const int l = e / (BATCH * MODW), n = e % MODW;
            float s = args.ada_b[l * MODW + n];
#pragma unroll
            for (int kc = 0; kc < 16; ++kc) s += MODP[(size_t)kc * NLAYER * BATCH * MODW + e];
            MOD[e] = s; }
        SEAM(1);
    }
    if (IN(2)) {
        SITE_IDS();
        for (int m = gw; m < M; m += NGW) { const int b = m >> 11;
#pragma unroll
            for (int j = 0; j < 8; ++j) { const int col = 4 * lane + 256 * j;
                const f32x4 xv = *(const f32x4*)(args.x + (size_t)m * D + col);
                const f32x4 sc = *(const f32x4*)(MOD + (size_t)b * MODW + 1 * D + col), sh = *(const f32x4*)(MOD + (size_t)b * MODW + 0 * D + col);
                const f32x4 hv = xv * (sc + 1.0f) + sh; u32x2 w; w.x = pkh(hv[0], hv[1]); w.y = pkh(hv[2], hv[3]);
                *(u32x2*)(Hb + (size_t)m * D + col) = w; } }
        SEAM(2);
    }

    for (int l_ = 0; l_ < NLAYER; ++l_) {
        const int l = opq_s(l_);
        const int pb = 3 + 8 * l, j = l >> 1;
        const float* modl = MOD + (size_t)l * BATCH * MODW;
        h16* W13 = Wb + W_FFN0 + (size_t)l * W_FFN_SZ; h16* W2 = W13 + W_13_SZ;
        if ((l & 1) == 0) {
            h16* Wd = Wb + W_MLA0 + (size_t)j * W_MLA_SZ; h16* Wu = Wd + W_DOWN_SZ; h16* Wo = Wu + W_UP_SZ;
            h16* Qb = QKV; h16* KVb = QKV + (size_t)M * QN;
            if (IN(pb + 0)) {
                REP_FOR(2) {
                pg8::Gemm g{Hb, Wd, M, LATP, D, D, 1 << 30, 0}; pg8::StaticOrder S; S.init(M, LATP, G, bx);
                pg8::EpiDown E{LAT, SSP, ROPE};
                pg8::gemm_phase<pg8::EpiDown, pg8::StaticOrder, true, true>(lds, g, S, E);
                REP_BAR(2); }
                SEAM(pb + 0);
            }
            if (IN(pb + 1)) {
                REP_FOR(3) {
                pg8::Gemm g{LAT, Wu, M, UPN, QL, LATP, 12, QL}; pg8::StaticOrder S; S.init(M, UPN, G, bx);
                pg8::EpiUp E{Qb, KVb, SSP, ROPE};
                pg8::gemm_phase<pg8::EpiUp, pg8::StaticOrder, true, true>(lds, g, S, E);
                REP_BAR(3); }
                SEAM(pb + 1);
            }
            if (IN(pb + 2)) {
                REP_FOR(4) {
                att::attn_phase<0, false>((att::lptr)lds, vcu, G, Qb, KVb, KVb + NHEAD * NOPE, Ob, LAT + QL + KVL, BIAS);
                REP_BAR(4); }
                SEAM(pb + 2);
            }
            if (IN(pb + 3)) {
                REP_FOR(5) {
                pg8::Gemm g{Ob, Wo, M, D, D, D, 1 << 30, 0}; pg8::StaticOrder S; S.init(M, D, G, bx);
                pg8::EpiRes E{(l == 0) ? args.x : nullptr, X, REP_DUMMY(5) ? DUMH : X, modl + 2 * D, STATS, args.ln2_g + (l - 1) * D, args.ln2_b + (l - 1) * D};
                pg8::gemm_phase<pg8::EpiRes, pg8::StaticOrder, true, true>(lds, g, S, E);
                REP_BAR(5); }
                SEAM(pb + 3);
            }
        } else {
            h16* Wi = Wb + W_FOX0 + (size_t)j * W_FOX_SZ; h16* Wo = Wi + W_IN_SZ;
            if (IN(pb + 0)) {
                REP_FOR(6) {
                pg8::Gemm g{Hb, Wi, M, PROJP, D, D, 1 << 30, 0}; pg8::StaticOrder S; S.init(M, PROJP, G, bx);
                pg8::EpiProj E{QKV};
                pg8::gemm_phase<pg8::EpiProj, pg8::StaticOrder, true, true>(lds, g, S, E);
                for (int rb = vcu; rb < M / 32; rb += G) fgate_rows(lds, Hb, Wi + (size_t)PROJP * D, args.fox_bf + j * NHEAD, LOGF, rb * 32);
                REP_BAR(6); }
                SEAM(pb + 0);
            }
            if (IN(pb + 1)) {
                SITE_IDS();
                LAS float* wsum = (LAS float*)lds;
                for (int u = bx; u < BATCH * NHEAD; u += G) { const int b = u >> 4, h = u & 15;
                    float v[4];
#pragma unroll
                    for (int q = 0; q < 4; ++q) v[q] = LOGF[((size_t)b * SEQ + 4 * tid + q) * 16 + h];
                    v[1] += v[0]; v[2] += v[1]; v[3] += v[2];
                    float inc = v[3];
#pragma unroll
                    for (int d = 1; d < 64; d <<= 1) { const float t = __shfl_up(inc, d); if (lane >= d) inc += t; }
                    if (lane == 63) wsum[wave] = inc;
                    __syncthreads();
                    float base = inc - v[3];
                    for (int w = 0; w < wave; ++w) base += wsum[w];
                    f32x4 o; o[0] = -(base + v[0]) * LOG2E; o[1] = -(base + v[1]) * LOG2E; o[2] = -(base + v[2]) * LOG2E; o[3] = -(base + v[3]) * LOG2E;
                    *(f32x4*)(BIAS + (size_t)u * SEQ + 4 * tid) = o;
                    __syncthreads(); }
                SEAM(pb + 1);
            }
            if (IN(pb + 2)) {
                REP_FOR(7) {
                att::attn_phase<1, false>((att::lptr)lds, vcu, G, QKV, QKV + D, QKV + 2 * D, Ob, LAT, BIAS);
                REP_BAR(7); }
                SEAM(pb + 2);
            }
            if (IN(pb + 3)) {
                REP_FOR(5) {
                pg8::Gemm g{Ob, Wo, M, D, D, D, 1 << 30, 0}; pg8::StaticOrder S; S.init(M, D, G, bx);
                pg8::EpiRes E{(l == 0) ? args.x : nullptr, X, REP_DUMMY(5) ? DUMH : X, modl + 2 * D, STATS, args.ln2_g + (l - 1) * D, args.ln2_b + (l - 1) * D};
                pg8::gemm_phase<pg8::EpiRes, pg8::StaticOrder, true, true>(lds, g, S, E);
                REP_BAR(5); }
                SEAM(pb + 3);
            }
        }
        if (IN(pb + 4)) {
            REP_FOR(8) {
            SITE_IDS();
            ln_phase(gw, NGW, lane, X, nullptr, REP_DUMMY(8) ? DUMX : STATS, REP_DUMMY(8) ? DUMH : Hb, args.ln1_g + l * D, args.ln1_b + l * D, modl, 4, 3);
            REP_BAR(8); }
            SEAM(pb + 4);
        }
        if (IN(pb + 5)) {
            REP_FOR(9) {
            pg8::Gemm g{Hb, W13, M, 2 * FF, D, D, 1 << 30, 0}; pg8::StaticOrder S; S.init(M, 2 * FF, G, bx);
            pg8::EpiSwiglu E{HH};
            pg8::gemm_phase<pg8::EpiSwiglu, pg8::StaticOrder, true, true>(lds, g, S, E);
            REP_BAR(9); }
            SEAM(pb + 5);
        }
        if (IN(pb + 6)) {
            REP_FOR(10) {
            pg8::Gemm g{HH, W2, M, D, FF, FF, 1 << 30, 0}; pg8::StaticOrder S; S.init(M, D, G, bx);
            pg8::EpiRes E{nullptr, X, REP_DUMMY(10) ? DUMH : X, modl + 5 * D, STATS, args.ln1_g + l * D, args.ln1_b + l * D};
            pg8::gemm_phase<pg8::EpiRes, pg8::StaticOrder, true, true>(lds, g, S, E);
            REP_BAR(10); }
            SEAM(pb + 6);
        }
        if (IN(pb + 7)) {
            REP_FOR(8) {
            SITE_IDS();
            if (l + 1 < NLAYER) ln_phase(gw, NGW, lane, X, nullptr, REP_DUMMY(8) ? DUMX : STATS, REP_DUMMY(8) ? DUMH : Hb, args.ln2_g + l * D, args.ln2_b + l * D, modl + (size_t)BATCH * MODW, 1, 0);
            else ln_phase(gw, NGW, lane, X, REP_DUMMY(8) ? DUMX : args.out, nullptr, nullptr, args.ln2_g + l * D, args.ln2_b + l * D, modl, 1, 0);
            REP_BAR(8); }
            SEAM(pb + 7);
        }
    }
#undef IN
#undef SEAM
#undef NREP
#undef REP_FOR
#undef REP_DUMMY
#undef REP_BAR
}

extern "C" void kernel_launch(void* const* d_in, const int* in_sizes, int n_in, void* d_out, int out_size, void* d_ws, size_t ws_size, hipStream_t stream) {
    static int grid = 0;
    if (grid == 0) {
        if (n_in != 22 || in_sizes[0] != M * D || out_size != M * D || ws_size < WS_END) {
            fprintf(stderr, "kernel_launch: shape/workspace mismatch (n_in %d, in0 %d, out %d, ws %zu, need %zu); nothing launched\n", n_in, n_in > 0 ? in_sizes[0] : -1, out_size, ws_size, (size_t)WS_END); grid = -1; return; }
        int dev = 0, cus = 0, per_cu = 0;
        if (hipGetDevice(&dev) != hipSuccess || hipDeviceGetAttribute(&cus, hipDeviceAttributeMultiprocessorCount, dev) != hipSuccess) { grid = -1; return; }
        if (hipFuncSetAttribute((const void*)trunk_fwd, hipFuncAttributeMaxDynamicSharedMemorySize, LDS_BYTES) != hipSuccess) { fprintf(stderr, "kernel_launch: hipFuncSetAttribute failed\n"); grid = -1; return; }
        if (hipOccupancyMaxActiveBlocksPerMultiprocessor(&per_cu, (const void*)trunk_fwd, NWAVES * 64, LDS_BYTES) != hipSuccess || per_cu < 1)
            fprintf(stderr, "kernel_launch: note: occupancy query reports %d workgroups per CU\n", per_cu);
        (void)hipGetLastError();
        grid = cus;
    }
    if (grid < 0) return;
    if (hipMemsetAsync((char*)d_ws + WS_CTL, 0, CTL_ZERO_BYTES, stream) != hipSuccess) return;
    Args a{};
    a.x = (const float*)d_in[0]; a.c = (const float*)d_in[1]; a.pos = (const int*)d_in[2]; a.ada_w = (const float*)d_in[3]; a.ada_b = (const float*)d_in[4];
    a.ln1_g = (const float*)d_in[5]; a.ln1_b = (const float*)d_in[6]; a.ln2_g = (const float*)d_in[7]; a.ln2_b = (const float*)d_in[8];
    a.w1 = (const float*)d_in[9]; a.w3 = (const float*)d_in[10]; a.w2 = (const float*)d_in[11];
    a.w_down = (const float*)d_in[12]; a.q_norm = (const float*)d_in[13]; a.w_uq = (const float*)d_in[14]; a.kv_norm = (const float*)d_in[15];
    a.w_uk = (const float*)d_in[16]; a.w_uv = (const float*)d_in[17]; a.mla_wo = (const float*)d_in[18];
    a.fox_win = (const float*)d_in[19]; a.fox_bf = (const float*)d_in[20]; a.fox_wo = (const float*)d_in[21];
    a.out = (float*)d_out; a.ws = (unsigned char*)d_ws;
#if MK_PER_PHASE
    for (int p = 0; p < NPHASE; ++p) { a.ph_lo = p; a.ph_hi = p + 1; hipLaunchKernelGGL(trunk_fwd, dim3(grid), dim3(NWAVES * 64), LDS_BYTES, stream, a); }
#else
    a.ph_lo = 0; a.ph_hi = NPHASE;
    hipLaunchKernelGGL(trunk_fwd, dim3(grid), dim3(NWAVES * 64), LDS_BYTES, stream, a);
#endif
    const hipError_t le = hipPeekAtLastError();
    if (le != hipSuccess) fprintf(stderr, "kernel_launch: launch failed: %s\n", hipGetErrorName(le));
}
```

```cpp
#include <hip/hip_runtime.h>
#include <cstdio>
#include <cstdint>

#ifndef PROBE_DUP
#define PROBE_DUP 0
#endif
#ifndef MK_PER_PHASE
#define MK_PER_PHASE 0
#endif

#define LAS __attribute__((address_space(3)))
#define GAS __attribute__((address_space(1)))
typedef _Float16 h16;
typedef _Float16 f16x8 __attribute__((ext_vector_type(8)));
typedef _Float16 f16x2 __attribute__((ext_vector_type(2)));
typedef short s16x4 __attribute__((ext_vector_type(4)));
typedef float f32x2 __attribute__((ext_vector_type(2)));
typedef float f32x4 __attribute__((ext_vector_type(4)));
typedef float f32x16 __attribute__((ext_vector_type(16)));
typedef unsigned u32x2 __attribute__((ext_vector_type(2)));
typedef unsigned u32x4 __attribute__((ext_vector_type(4)));

constexpr int BATCH = 4, SEQ = 2048, M = BATCH * SEQ, D = 2048, NLAYER = 4, FF = 5632;
constexpr int NHEAD = 16, QL = 512, KVL = 512, ROPE_D = 64, NOPE = 128, VD = 128, QKD = NOPE + ROPE_D;
constexpr int LATN = QL + KVL + ROPE_D, LATP = 1280;
constexpr int QN = NHEAD * QKD, KVN = 2 * NHEAD * NOPE, UPN = QN + KVN;
constexpr int PROJN = 3 * D + NHEAD, PROJNP = 6400, PROJP = 3 * D;
constexpr int MODW = 6 * D;
constexpr float DN_ALPHA = 1.6817928305074290f;
constexpr float LN_EPS = 1e-5f, RMS_EPS = 1e-6f;
constexpr float LOG2E = 1.4426950408889634f;

constexpr size_t MiB = 1u << 20;
constexpr size_t WS_CTL = 0, CTL_ZERO_BYTES = 1 * MiB;
constexpr size_t WS_MOD = 1 * MiB;
constexpr size_t WS_SSP = 2 * MiB;
constexpr size_t WS_LOGF = 3 * MiB;
constexpr size_t WS_BIAS = 4 * MiB;
constexpr size_t WS_ROPE = 5 * MiB;
constexpr size_t WS_STATS = 7 * MiB;
constexpr size_t WS_MODP = 8 * MiB;
constexpr size_t WS_X = 24 * MiB;
constexpr size_t WS_H = 88 * MiB;
constexpr size_t WS_LAT = 120 * MiB;
constexpr size_t WS_O = 140 * MiB;
constexpr size_t WS_QKV = 172 * MiB;
constexpr size_t WS_KVOFF = (size_t)M * QN * 2;
constexpr size_t WS_HH = 284 * MiB;
constexpr size_t WS_W = 372 * MiB;
constexpr size_t W_DOWN_SZ = (size_t)LATP * D, W_UP_SZ = (size_t)UPN * QL, W_O_SZ = (size_t)D * D, W_IN_SZ = (size_t)PROJNP * D, W_13_SZ = (size_t)2 * FF * D, W_2_SZ = (size_t)D * FF;
constexpr size_t W_MLA_SZ = W_DOWN_SZ + W_UP_SZ + W_O_SZ, W_FOX_SZ = W_IN_SZ + W_O_SZ, W_FFN_SZ = W_13_SZ + W_2_SZ;
constexpr size_t W_MLA0 = 0, W_FOX0 = 2 * W_MLA_SZ, W_FFN0 = W_FOX0 + 2 * W_FOX_SZ, W_TOTAL = W_FFN0 + 4 * W_FFN_SZ;
constexpr size_t WS_WEND = WS_W + W_TOTAL * 2;
#if PROBE_DUP
constexpr size_t WS_DUMX = (WS_WEND + MiB - 1) / MiB * MiB, WS_DUMH = WS_DUMX + 64 * MiB, WS_END = WS_DUMH + 32 * MiB;
#else
constexpr size_t WS_DUMX = WS_X, WS_DUMH = WS_H, WS_END = WS_WEND;
#endif

constexpr int CW_BAR = 4096;

constexpr int RING_BYTES = 139264;
constexpr int LDSCTL_OFF = RING_BYTES, MISC_OFF = LDSCTL_OFF + 320;
constexpr int LDS_BYTES = 147456;
constexpr int NWAVES = 8;

#define LDS_WAIT() asm volatile("s_waitcnt lgkmcnt(0)" ::: "memory")
#define VM_WAIT() asm volatile("s_waitcnt vmcnt(0)" ::: "memory")

__device__ __forceinline__ int opq_v(int v) { asm volatile("" : "+v"(v)); return v; }
__device__ __forceinline__ int opq_s(int v) { asm volatile("" : "+s"(v)); return v; }
__device__ __forceinline__ unsigned pkh(float lo, float hi) { f16x2 v = {(h16)lo, (h16)hi}; return __builtin_bit_cast(unsigned, v); }
__device__ __forceinline__ u32x4 pk8(f32x4 a, f32x4 b) { u32x4 w; w.x = pkh(a[0], a[1]); w.y = pkh(a[2], a[3]); w.z = pkh(b[0], b[1]); w.w = pkh(b[2], b[3]); return w; }

namespace pg8 {
constexpr int BM = 256, BK = 64, HALF = 128, HTB = HALF * BK * 2, STAGE_BYTES = 8 * HTB, NXCD = 8, WGM = 8;
__host__ __device__ __forceinline__ int lds_byte(int r, int c) { const int st = (r >> 4) * 2 + (c >> 5), rr = r & 15, cc = c & 31, ob = rr * 64 + cc * 2; return st * 1024 + (ob ^ (((ob >> 9) & 1) << 5)); }
__host__ __device__ __forceinline__ void stage_rc(int b, int& R, int& C) { const int st = b / 1024, sb = b % 1024, swz = sb ^ (((sb >> 9) & 1) << 5); R = (st >> 1) * 16 + swz / 64; C = (st & 1) * 32 + (swz % 64) / 2; }
__host__ __device__ __forceinline__ int perm32(int rho) { const int n = rho >> 4, i = rho & 15; return 8 * (i >> 2) + 4 * n + (i & 3); }

struct Unit { int pm, pn; };
struct Gemm { const h16* A; const h16* Bt; int M, N, K, lda; int split_pn, split_off; };

struct StaticOrder {
    int nM, nN, nwg, G, c;
    __device__ void init(int M_, int N_, int G_, int c_) { nM = M_ / BM; nN = N_ / BM; nwg = nM * nN; G = G_; c = c_; }
    __device__ bool next(int i, Unit& u) const {
        const long L = (long)i * G + c; if (L >= nwg) return false;
        int wgid = (int)L; { const int q = nwg / NXCD, r = nwg % NXCD, xcd = wgid % NXCD, off = wgid / NXCD; wgid = (xcd < r ? xcd * (q + 1) : r * (q + 1) + (xcd - r) * q) + off; }
        const int nig = WGM * nN, gid = wgid / nig, fm = gid * WGM, gsz = (nM - fm) < WGM ? (nM - fm) : WGM;
        u.pm = fm + ((wgid % nig) % gsz); u.pn = (wgid % nig) / gsz; return true;
    }
};

typedef f32x4 Acc[2][2][4][2];

template <class Epi, class Sched, bool ALIGN_EPI, bool SP2>
__device__ __forceinline__ void gemm_phase(LAS unsigned char* lds, const Gemm g, const Sched& S, const Epi& E) {
    const int tid = opq_v((int)threadIdx.x), wid = __builtin_amdgcn_readfirstlane(tid >> 6), lane = tid & 63, wr = wid >> 2, wc = wid & 3, fr = lane & 15, fq = lane >> 4;
    const int K = g.K, nt = K / BK, lda = g.lda;
    unsigned voffA[2], voffB[2];
#pragma unroll
    for (int i = 0; i < 2; ++i) { int R, C; stage_rc(tid * 16 + i * 8192, R, C); const int Rb = Epi::PERM ? ((R & ~31) + perm32(R & 31)) : R;
        voffA[i] = (unsigned)(R * lda + C) * 2u; voffB[i] = (unsigned)(Rb * K + C) * 2u; }
    const size_t kstep = (size_t)(BK * 2);
    const size_t hstepA = (size_t)HALF * lda * 2, hstepB = (size_t)HALF * K * 2;
    const size_t tstepA = 2 * hstepA, tstepB = 2 * hstepB;
    const unsigned ldsw = (unsigned)wid * 1024u;
    const int aoff = lds_byte(wr * 64 + fr, fq * 8), boff = lds_byte(wc * 32 + fr, fq * 8);
#define PG8_SA(b, h) (((b) * 2 + (h)) * HTB)
#define PG8_SB(b, h) ((4 + (b) * 2 + (h)) * HTB)
#define PG8_STAGE(bufoff, gbase, voff) do { _Pragma("unroll") for (int _i = 0; _i < 2; ++_i) \
        __builtin_amdgcn_global_load_lds((const unsigned*)((const char*)(gbase) + (voff)[_i]), (LAS unsigned*)(lds + (bufoff) + ldsw + _i * 8192), 16, 0, 0); } while (0)
#define PG8_LDA(dst, b, h) do { _Pragma("unroll") for (int m = 0; m < 4; ++m) _Pragma("unroll") for (int k = 0; k < 2; ++k) dst[m][k] = *(const LAS f16x8*)(lds + PG8_SA(b, h) + aoff + m * 2048 + k * 1024); } while (0)
#define PG8_LDB(dst, b, h) do { _Pragma("unroll") for (int n = 0; n < 2; ++n) _Pragma("unroll") for (int k = 0; k < 2; ++k) dst[n][k] = *(const LAS f16x8*)(lds + PG8_SB(b, h) + boff + n * 2048 + k * 1024); } while (0)
#define PG8_MMA(ai, bj, At, Bt) do { __builtin_amdgcn_s_setprio(1); _Pragma("unroll") for (int m = 0; m < 4; ++m) _Pragma("unroll") for (int n = 0; n < 2; ++n) _Pragma("unroll") for (int k = 0; k < 2; ++k) \
        acc[ai][bj][m][n] = __builtin_amdgcn_mfma_f32_16x16x32_f16(Bt[n][k], At[m][k], acc[ai][bj][m][n], 0, 0, 0); __builtin_amdgcn_s_setprio(0); } while (0)
#define PG8_WAIT_V(n) asm volatile("s_waitcnt vmcnt(" #n ")" ::: "memory")
#define PG8_WAIT_L(n) asm volatile("s_waitcnt lgkmcnt(" #n ")" ::: "memory")
#define PG8_BAR __builtin_amdgcn_s_barrier()
#define PG8_SCHED __builtin_amdgcn_sched_barrier(0)
#define PG8_AOFF(u) ((size_t)(u).pm * tstepA + ((u).pn >= g.split_pn ? (size_t)g.split_off * 2 : (size_t)0))
    Unit cur, nxt; int ui = 0;
    if (!S.next(0, cur)) return;
    Acc acc;
#pragma unroll
    for (int a = 0; a < 2; ++a)
#pragma unroll
        for (int b = 0; b < 2; ++b)
#pragma unroll
            for (int m = 0; m < 4; ++m)
#pragma unroll
                for (int n = 0; n < 2; ++n) acc[a][b][m][n] = (f32x4){0.f, 0.f, 0.f, 0.f};
    f16x8 At[4][2], B0[2][2], B1[2][2];
    const char* cA = (const char*)g.A + PG8_AOFF(cur); const char* cB = (const char*)g.Bt + (size_t)cur.pn * tstepB;
    if constexpr (SP2) {
        PG8_STAGE(PG8_SB(0, 0), cB, voffB); PG8_STAGE(PG8_SB(0, 1), cB + hstepB, voffB); PG8_STAGE(PG8_SA(0, 0), cA, voffA); PG8_STAGE(PG8_SA(0, 1), cA + hstepA, voffA);
        if (wr == 1) PG8_BAR;
        PG8_WAIT_V(2); PG8_BAR;
        PG8_STAGE(PG8_SB(1, 0), cB + kstep, voffB); PG8_STAGE(PG8_SA(1, 0), cA + kstep, voffA); PG8_STAGE(PG8_SB(1, 1), cB + hstepB + kstep, voffB);
        PG8_WAIT_V(6); PG8_BAR;
    } else {
        PG8_STAGE(PG8_SB(0, 0), cB, voffB); PG8_STAGE(PG8_SA(0, 0), cA, voffA); PG8_STAGE(PG8_SB(0, 1), cB + hstepB, voffB); PG8_STAGE(PG8_SA(0, 1), cA + hstepA, voffA);
        if (wr == 1) PG8_BAR;
        PG8_WAIT_V(4); PG8_BAR;
        PG8_STAGE(PG8_SB(1, 0), cB + kstep, voffB); PG8_STAGE(PG8_SA(1, 0), cA + kstep, voffA); PG8_STAGE(PG8_SB(1, 1), cB + hstepB + kstep, voffB);
        PG8_WAIT_V(6); PG8_BAR;
    }
    for (;;) {
        const bool has_next = S.next(ui + 1, nxt);
        const char* nA = has_next ? (const char*)g.A + PG8_AOFF(nxt) : cA; const char* nB = has_next ? (const char*)g.Bt + (size_t)nxt.pn * tstepB : cB;
        for (int t = 0; t < nt; t += 2) {
            const bool last = (t == nt - 2);
            const char* a1 = cA + (size_t)(t + 1) * kstep;
            const char* a2 = last ? nA : cA + (size_t)(t + 2) * kstep; const char* b2 = last ? nB : cB + (size_t)(t + 2) * kstep;
            const char* a3 = a2 + kstep; const char* b3 = b2 + kstep;
            if constexpr (SP2) {
            PG8_LDB(B0, 0, 0); PG8_LDB(B1, 0, 1); PG8_SCHED; PG8_LDA(At, 0, 0); PG8_STAGE(PG8_SA(1, 1), a1 + hstepA, voffA);
            PG8_WAIT_V(8); PG8_WAIT_L(0); PG8_BAR; PG8_MMA(0, 0, At, B0); PG8_MMA(0, 1, At, B1); PG8_BAR; PG8_SCHED;
            PG8_LDA(At, 0, 1); PG8_STAGE(PG8_SB(0, 0), b2, voffB); PG8_STAGE(PG8_SB(0, 1), b2 + hstepB, voffB); PG8_STAGE(PG8_SA(0, 0), a2, voffA);
            PG8_WAIT_V(8); PG8_WAIT_L(0); PG8_BAR; PG8_MMA(1, 0, At, B0); PG8_MMA(1, 1, At, B1); PG8_BAR; PG8_SCHED;
            PG8_LDB(B0, 1, 0); PG8_LDB(B1, 1, 1); PG8_SCHED; PG8_LDA(At, 1, 0); PG8_STAGE(PG8_SA(0, 1), a2 + hstepA, voffA);
            PG8_WAIT_V(8); PG8_WAIT_L(0); PG8_BAR; PG8_MMA(0, 0, At, B0); PG8_MMA(0, 1, At, B1); PG8_BAR; PG8_SCHED;
            PG8_LDA(At, 1, 1); PG8_STAGE(PG8_SB(1, 0), b3, voffB); PG8_STAGE(PG8_SB(1, 1), b3 + hstepB, voffB); PG8_STAGE(PG8_SA(1, 0), a3, voffA);
            PG8_WAIT_V(8); PG8_WAIT_L(0); PG8_BAR; PG8_MMA(1, 0, At, B0); PG8_MMA(1, 1, At, B1); PG8_BAR; PG8_SCHED;
            } else {
            PG8_LDB(B0, 0, 0); PG8_SCHED; PG8_LDA(At, 0, 0); PG8_STAGE(PG8_SA(1, 1), a1 + hstepA, voffA);
            PG8_WAIT_L(8); PG8_BAR; PG8_WAIT_L(0); PG8_MMA(0, 0, At, B0); PG8_BAR; PG8_SCHED;
            PG8_LDB(B1, 0, 1); PG8_STAGE(PG8_SB(0, 0), b2, voffB);
            PG8_BAR; PG8_WAIT_L(0); PG8_MMA(0, 1, At, B1); PG8_BAR;
            PG8_LDA(At, 0, 1); PG8_STAGE(PG8_SA(0, 0), a2, voffA);
            PG8_BAR; PG8_WAIT_L(0); PG8_MMA(1, 0, At, B0); PG8_BAR; PG8_SCHED;
            PG8_STAGE(PG8_SB(0, 1), b2 + hstepB, voffB);
            PG8_WAIT_V(6); PG8_BAR; PG8_MMA(1, 1, At, B1); PG8_BAR;
            PG8_LDB(B0, 1, 0); PG8_SCHED; PG8_LDA(At, 1, 0); PG8_STAGE(PG8_SA(0, 1), a2 + hstepA, voffA);
            PG8_WAIT_L(8); PG8_BAR; PG8_WAIT_L(0); PG8_MMA(0, 0, At, B0); PG8_BAR; PG8_SCHED;
            PG8_LDB(B1, 1, 1); PG8_STAGE(PG8_SB(1, 0), b3, voffB);
            PG8_BAR; PG8_WAIT_L(0); PG8_MMA(0, 1, At, B1); PG8_BAR;
            PG8_LDA(At, 1, 1); PG8_STAGE(PG8_SA(1, 0), a3, voffA);
            PG8_BAR; PG8_WAIT_L(0); PG8_MMA(1, 0, At, B0); PG8_BAR; PG8_SCHED;
            PG8_STAGE(PG8_SB(1, 1), b3 + hstepB, voffB);
            PG8_WAIT_V(6); PG8_BAR; PG8_MMA(1, 1, At, B1); PG8_BAR;
            }
        }
        if constexpr (ALIGN_EPI) { if (wr == 0) PG8_BAR; }
        E(acc, cur, wr, wc, fr, fq);
        if (!has_next) break;
#pragma unroll
        for (int a = 0; a < 2; ++a)
#pragma unroll
            for (int b = 0; b < 2; ++b)
#pragma unroll
                for (int m = 0; m < 4; ++m)
#pragma unroll
                    for (int n = 0; n < 2; ++n) acc[a][b][m][n] = (f32x4){0.f, 0.f, 0.f, 0.f};
        cur = nxt; cA = nA; cB = nB; ++ui;
        if constexpr (ALIGN_EPI) { if (wr == 1) PG8_BAR; }
    }
    PG8_WAIT_V(0);
    if constexpr (!ALIGN_EPI) { if (wr == 0) PG8_BAR; }
    PG8_BAR;
#undef PG8_SA
#undef PG8_SB
#undef PG8_STAGE
#undef PG8_LDA
#undef PG8_LDB
#undef PG8_MMA
#undef PG8_WAIT_V
#undef PG8_WAIT_L
#undef PG8_BAR
#undef PG8_SCHED
#undef PG8_AOFF
}

__device__ __forceinline__ void rope4(f32x4& v0, f32x4& v1, const float* cs) {
    const f32x4 a = *(const f32x4*)cs, b = *(const f32x4*)(cs + 4);
    f32x4 o0, o1;
    o0[0] = v0[0] * a[0] - v0[1] * a[1]; o0[1] = v0[0] * a[1] + v0[1] * a[0];
    o0[2] = v0[2] * a[2] - v0[3] * a[3]; o0[3] = v0[2] * a[3] + v0[3] * a[2];
    o1[0] = v1[0] * b[0] - v1[1] * b[1]; o1[1] = v1[0] * b[1] + v1[1] * b[0];
    o1[2] = v1[2] * b[2] - v1[3] * b[3]; o1[3] = v1[2] * b[3] + v1[3] * b[2];
    v0 = o0; v1 = o1;
}
struct EpiDown {
    static constexpr bool PERM = true;
    h16* LAT; float* SSP; const float* ROPE;
    __device__ __forceinline__ void operator()(const Acc& acc, const Unit& u, int wr, int wc, int fr, int fq) const {
        const int col0 = u.pn * BM + wc * 32 + 8 * fq;
#pragma unroll
        for (int ai = 0; ai < 2; ++ai)
#pragma unroll
            for (int m = 0; m < 4; ++m) {
                const int row = u.pm * BM + ai * HALF + wr * 64 + m * 16 + fr; float ss = 0.f;
#pragma unroll
                for (int bj = 0; bj < 2; ++bj) { f32x4 v0 = acc[ai][bj][m][0], v1 = acc[ai][bj][m][1];
                    ss += (v0[0] * v0[0] + v0[1] * v0[1]) + (v0[2] * v0[2] + v0[3] * v0[3]) + (v1[0] * v1[0] + v1[1] * v1[1]) + (v1[2] * v1[2] + v1[3] * v1[3]);
                    if (u.pn == 4 && bj == 0 && wc < 2) rope4(v0, v1, ROPE + ((size_t)row * 32 + 16 * wc + 4 * fq) * 2);
                    *(u32x4*)(LAT + (size_t)row * LATP + col0 + bj * HALF) = pk8(v0, v1); }
                if (u.pn < 4) { ss += __shfl_xor(ss, 16); ss += __shfl_xor(ss, 32); if (fq == 0) SSP[(size_t)row * 16 + u.pn * 4 + wc] = ss; }
            }
    }
};
struct EpiUp {
    static constexpr bool PERM = true;
    h16* Q; h16* KV; const float* SSP; const float* ROPE;
    __device__ __forceinline__ void operator()(const Acc& acc, const Unit& u, int wr, int wc, int fr, int fq) const {
        const bool isq = u.pn < 12;
        const int colt = (isq ? u.pn : u.pn - 12) * BM + wc * 32 + 8 * fq;
#pragma unroll
        for (int ai = 0; ai < 2; ++ai)
#pragma unroll
            for (int m = 0; m < 4; ++m) {
                const int row = u.pm * BM + ai * HALF + wr * 64 + m * 16 + fr;
                const f32x4* sp = (const f32x4*)(SSP + (size_t)row * 16 + (isq ? 0 : 8)); const f32x4 s0 = sp[0], s1 = sp[1];
                const float ss = ((s0[0] + s0[1]) + (s0[2] + s0[3])) + ((s1[0] + s1[1]) + (s1[2] + s1[3]));
                const float rstd = 1.0f / sqrtf(ss * (1.0f / 512.0f) + RMS_EPS);
#pragma unroll
                for (int bj = 0; bj < 2; ++bj) { f32x4 v0 = acc[ai][bj][m][0] * rstd, v1 = acc[ai][bj][m][1] * rstd; const int col = colt + bj * HALF;
                    if (isq) { const int within = col % QKD;
                        if (within >= NOPE) rope4(v0, v1, ROPE + ((size_t)row * 32 + ((within - NOPE) >> 1)) * 2);
                        *(u32x4*)(Q + (size_t)row * QN + col) = pk8(v0, v1); }
                    else *(u32x4*)(KV + (size_t)row * KVN + col) = pk8(v0, v1); }
            }
    }
};
struct EpiProj {
    static constexpr bool PERM = true;
    h16* P;
    __device__ __forceinline__ void operator()(const Acc& acc, const Unit& u, int wr, int wc, int fr, int fq) const {
        const int col0 = u.pn * BM + wc * 32 + 8 * fq;
#pragma unroll
        for (int ai = 0; ai < 2; ++ai)
#pragma unroll
            for (int m = 0; m < 4; ++m) { const int row = u.pm * BM + ai * HALF + wr * 64 + m * 16 + fr;
#pragma unroll
                for (int bj = 0; bj < 2; ++bj) *(u32x4*)(P + (size_t)row * PROJP + col0 + bj * HALF) = pk8(acc[ai][bj][m][0], acc[ai][bj][m][1]); }
    }
};
struct EpiSwiglu {
    static constexpr bool PERM = true;
    h16* HH;
    __device__ __forceinline__ void operator()(const Acc& acc, const Unit& u, int wr, int wc, int fr, int fq) const {
        const int col0 = u.pn * HALF + wc * 32 + 8 * fq;
#pragma unroll
        for (int ai = 0; ai < 2; ++ai)
#pragma unroll
            for (int m = 0; m < 4; ++m) { const int row = u.pm * BM + ai * HALF + wr * 64 + m * 16 + fr; f32x4 h0, h1;
#pragma unroll
                for (int e = 0; e < 4; ++e) { const float g0 = acc[ai][0][m][0][e], g1 = acc[ai][0][m][1][e];
                    h0[e] = g0 * __builtin_amdgcn_rcpf(1.0f + __expf(-g0)) * acc[ai][1][m][0][e]; h1[e] = g1 * __builtin_amdgcn_rcpf(1.0f + __expf(-g1)) * acc[ai][1][m][1][e]; }
                *(u32x4*)(HH + (size_t)row * FF + col0) = pk8(h0, h1); }
    }
};
struct EpiRes {
    static constexpr bool PERM = true;
    const float* xin32; const h16* xin16; h16* X; const float* gate; const float* st; const float* lg; const float* lb;
    __device__ __forceinline__ void operator()(const Acc& acc, const Unit& u, int wr, int wc, int fr, int fq) const {
        const int col0 = u.pn * BM + wc * 32 + 8 * fq; const float* gp = gate + (size_t)(u.pm >> 3) * MODW + col0;
        f32x4 gv[2][2], lgv[2][2], lbv[2][2];
#pragma unroll
        for (int bj = 0; bj < 2; ++bj)
#pragma unroll
            for (int n = 0; n < 2; ++n) { gv[bj][n] = *(const f32x4*)(gp + bj * HALF + 4 * n) + 1.0f;
                if (!xin32) { lgv[bj][n] = *(const f32x4*)(lg + col0 + bj * HALF + 4 * n) * DN_ALPHA; lbv[bj][n] = *(const f32x4*)(lb + col0 + bj * HALF + 4 * n) * DN_ALPHA; } }
#pragma unroll
        for (int ai = 0; ai < 2; ++ai)
#pragma unroll
            for (int m = 0; m < 4; ++m) { const int row = u.pm * BM + ai * HALF + wr * 64 + m * 16 + fr; const size_t off = (size_t)row * D + col0;
                f32x2 ms = {0.f, 0.f}; if (!xin32) ms = *(const f32x2*)(st + (size_t)row * 2);
#pragma unroll
                for (int bj = 0; bj < 2; ++bj) { f32x4 xa0, xa1;
                    if (xin32) { xa0 = *(const f32x4*)(xin32 + off + bj * HALF) * DN_ALPHA; xa1 = *(const f32x4*)(xin32 + off + bj * HALF + 4) * DN_ALPHA; }
                    else { const f16x8 xv = *(const f16x8*)(xin16 + off + bj * HALF);
                        f32x4 x0 = {(float)xv[0], (float)xv[1], (float)xv[2], (float)xv[3]}, x1 = {(float)xv[4], (float)xv[5], (float)xv[6], (float)xv[7]};
                        xa0 = (x0 - ms[0]) * ms[1] * lgv[bj][0] + lbv[bj][0]; xa1 = (x1 - ms[0]) * ms[1] * lgv[bj][1] + lbv[bj][1]; }
                    *(u32x4*)(X + off + bj * HALF) = pk8(xa0 + gv[bj][0] * acc[ai][bj][m][0], xa1 + gv[bj][1] * acc[ai][bj][m][1]); } }
    }
};
}

namespace att {
constexpr int NW = 8, QBLK = 32, KVBLK = 64, QB = NW * QBLK;
constexpr int SHM_V = KVBLK * 128 * 2;
constexpr int SHM_KMAX = KVBLK * 512;
constexpr int OFF_V = 0, OFF_K = 2 * SHM_V, OFF_WS = OFF_K + 2 * SHM_KMAX, OFF_BIAS = OFF_WS + NW * 64 * 4, ATT_LDS = OFF_BIAS + 2 * 64 * 4;
static_assert(ATT_LDS <= RING_BYTES, "attention LDS");
constexpr float THR = 8.f;
#define SBAR() __builtin_amdgcn_sched_barrier(0)
typedef LAS char* lptr;
__device__ __forceinline__ int v_st(int k, int c) { const int kk = (k & ~0xC) | ((k & 4) << 1) | ((k & 8) >> 1); return ((kk >> 3) * 4 + (c >> 5)) * 512 + ((kk & 7) * 32 + (c & 31)) * 2; }
__device__ __forceinline__ int v_rd_base(int lane) { return ((lane & 3) << 3) | (((lane >> 2) & 3) << 6) | (((lane >> 4) & 1) << 5) | (((lane >> 5) & 1) << 8); }
constexpr int v_rd_off(int d0, int ks, int half) { return d0 * 512 + ks * 4096 + half * 2048; }
__device__ __forceinline__ int crow(int r, int hi) { return (r & 3) + 8 * (r >> 2) + 4 * hi; }
__device__ __forceinline__ f16x8 ld8(const h16* p) { return *reinterpret_cast<const f16x8*>(p); }

template <int MODE> struct Cfg;
template <> struct Cfg<0> { static constexpr int KROWB = 512, NQF = 12, PQ = QN, PK = KVN, PV = KVN; static constexpr float SCALE = 0.07216878364870322f; };
template <> struct Cfg<1> { static constexpr int KROWB = 256, NQF = 8, PQ = PROJP, PK = PROJP, PV = PROJP; static constexpr float SCALE = 0.08838834764831845f; };

__device__ __forceinline__ void mask_tile(f32x16& p0, f32x16& p1, int dq) {
    const float NEG = -__builtin_inff();
#pragma unroll
    for (int r = 0; r < 16; ++r) { const int c = (r & 3) + 8 * (r >> 2);
        if (dq - c < 0) p0[r] = NEG;
        if (dq - c - 32 < 0) p1[r] = NEG; }
}
template <int MODE>
__device__ __forceinline__ void partialSM(f32x16& p0, f32x16& p1, float& m_reg, float& mn, float& alpha) {
    float pmax = p0[0];
#pragma unroll
    for (int r = 1; r < 16; ++r) pmax = fmaxf(pmax, p0[r]);
#pragma unroll
    for (int r = 0; r < 16; ++r) pmax = fmaxf(pmax, p1[r]);
    { auto rr = __builtin_amdgcn_permlane32_swap(__float_as_uint(pmax), __float_as_uint(pmax), false, false);
      pmax = fmaxf(__uint_as_float(rr[0]), __uint_as_float(rr[1])); }
    if constexpr (MODE == 0) {
        constexpr float SC = Cfg<0>::SCALE, C2 = LOG2E * SC;
        if (__builtin_expect(__all((pmax - m_reg) * SC <= THR), 1)) { mn = m_reg; alpha = 1.f; }
        else { mn = fmaxf(m_reg, pmax); alpha = __builtin_amdgcn_exp2f((m_reg - mn) * C2); m_reg = mn; }
        const float mnL = -mn * C2;
#pragma unroll
        for (int r = 0; r < 16; ++r) p0[r] = fmaf(p0[r], C2, mnL);
#pragma unroll
        for (int r = 0; r < 16; ++r) p1[r] = fmaf(p1[r], C2, mnL);
    } else {
        if (__builtin_expect(__all((pmax - m_reg) <= THR * LOG2E), 1)) { mn = m_reg; alpha = 1.f; }
        else { mn = fmaxf(m_reg, pmax); alpha = __builtin_amdgcn_exp2f(m_reg - mn); m_reg = mn; }
#pragma unroll
        for (int r = 0; r < 16; ++r) p0[r] = p0[r] - mn;
#pragma unroll
        for (int r = 0; r < 16; ++r) p1[r] = p1[r] - mn;
    }
#pragma unroll
    for (int r = 0; r < 16; ++r) p0[r] = __builtin_amdgcn_exp2f(p0[r]);
}
__device__ __forceinline__ void finishSM(f32x16& p0, f32x16& p1, float alpha, float& l_reg, f16x8& pa0, f16x8& pa1, f16x8& pa2, f16x8& pa3) {
#pragma unroll
    for (int r = 0; r < 16; ++r) p1[r] = __builtin_amdgcn_exp2f(p1[r]);
    float ps = 0;
#pragma unroll
    for (int r = 0; r < 16; ++r) ps += p0[r];
#pragma unroll
    for (int r = 0; r < 16; ++r) ps += p1[r];
    { auto rr = __builtin_amdgcn_permlane32_swap(__float_as_uint(ps), __float_as_uint(ps), false, false);
      ps = __uint_as_float(rr[0]) + __uint_as_float(rr[1]); }
    l_reg = l_reg * alpha + ps;
#define PK4(P, B_, OUT) do { unsigned a0 = pkh(P[B_+0], P[B_+1]), a1 = pkh(P[B_+2], P[B_+3]);                          \
        unsigned b0 = pkh(P[B_+4], P[B_+5]), b1 = pkh(P[B_+6], P[B_+7]);                                             \
        auto r0 = __builtin_amdgcn_permlane32_swap(a0, b0, false, false); auto r1 = __builtin_amdgcn_permlane32_swap(a1, b1, false, false); \
        u32x4 w = {r0[0], r1[0], r0[1], r1[1]}; OUT = __builtin_bit_cast(f16x8, w); } while (0)
    PK4(p0, 0, pa0); PK4(p0, 8, pa1); PK4(p1, 0, pa2); PK4(p1, 8, pa3);
#undef PK4
}
template <int MODE, int KB>
__device__ __forceinline__ void qkt(f32x16& p0, f32x16& p1, lptr K_lds, int r32, int hi, const f16x8* qr) {
    constexpr int KROWB = Cfg<MODE>::KROWB, NQF = Cfg<MODE>::NQF;
    p0 = f32x16{}; p1 = f32x16{};
    lptr kb[4];
#pragma unroll
    for (int dd = 0; dd < 4; ++dd) kb[dd] = K_lds + KB * SHM_KMAX + r32 * KROWB + (((dd * 16 + hi * 8) * 2) ^ ((r32 & 7) << 4));
#pragma unroll
    for (int d0 = 0; d0 < NQF; ++d0) { lptr a = kb[d0 & 3] + (d0 >> 2) * 128;
        const f16x8 b0 = *(const LAS f16x8*)(a);
        const f16x8 b1 = *(const LAS f16x8*)(a + 32 * KROWB);
        p0 = __builtin_amdgcn_mfma_f32_32x32x16_f16(b0, qr[d0], p0, 0, 0, 0);
        p1 = __builtin_amdgcn_mfma_f32_32x32x16_f16(b1, qr[d0], p1, 0, 0, 0); }
}
template <int MODE, int KB>
__device__ __forceinline__ void qkt2(f32x16& p0, f32x16& p1, const unsigned (&kbv)[8], const f16x8* qr) {
    constexpr int KROWB = Cfg<MODE>::KROWB, NQF = Cfg<MODE>::NQF, NG = NQF / 2, B0 = KB * SHM_KMAX, H = 32 * KROWB;
#define KRD(dst, d0) do { asm volatile("ds_read_b128 %0, %1 offset:%2" : "=&v"(dst[0]) : "v"(kbv[(d0) & 7]), "i"(B0 + ((d0) >> 3) * 256) : "memory");        \
                          asm volatile("ds_read_b128 %0, %1 offset:%2" : "=&v"(dst[1]) : "v"(kbv[(d0) & 7]), "i"(B0 + ((d0) >> 3) * 256 + H) : "memory"); } while (0)
    f16x8 ka[2][2], kb[2][2];
    p0 = f32x16{}; p1 = f32x16{};
    KRD(ka[0], 0); KRD(ka[1], 1); KRD(kb[0], 2); KRD(kb[1], 3);
#pragma unroll
    for (int g = 0; g < NG; ++g) {
        if (g + 1 < NG) asm volatile("s_waitcnt lgkmcnt(4)" ::: "memory"); else asm volatile("s_waitcnt lgkmcnt(0)" ::: "memory");
        SBAR();
        if ((g & 1) == 0) {
            p0 = __builtin_amdgcn_mfma_f32_32x32x16_f16(ka[0][0], qr[2 * g], p0, 0, 0, 0); p1 = __builtin_amdgcn_mfma_f32_32x32x16_f16(ka[0][1], qr[2 * g], p1, 0, 0, 0);
            p0 = __builtin_amdgcn_mfma_f32_32x32x16_f16(ka[1][0], qr[2 * g + 1], p0, 0, 0, 0); p1 = __builtin_amdgcn_mfma_f32_32x32x16_f16(ka[1][1], qr[2 * g + 1], p1, 0, 0, 0);
            SBAR();
            if (g + 2 < NG) { KRD(ka[0], 2 * g + 4); KRD(ka[1], 2 * g + 5); }
        } else {
            p0 = __builtin_amdgcn_mfma_f32_32x32x16_f16(kb[0][0], qr[2 * g], p0, 0, 0, 0); p1 = __builtin_amdgcn_mfma_f32_32x32x16_f16(kb[0][1], qr[2 * g], p1, 0, 0, 0);
            p0 = __builtin_amdgcn_mfma_f32_32x32x16_f16(kb[1][0], qr[2 * g + 1], p0, 0, 0, 0); p1 = __builtin_amdgcn_mfma_f32_32x32x16_f16(kb[1][1], qr[2 * g + 1], p1, 0, 0, 0);
            SBAR();
            if (g + 2 < NG) { KRD(kb[0], 2 * g + 4); KRD(kb[1], 2 * g + 5); }
        }
    }
#undef KRD
}
template <int VB>
__device__ __forceinline__ void pv_tile(f32x16* o, int vb0, f16x8 pa0, f16x8 pa1, f16x8 pa2, f16x8 pa3) {
#define TRRD(dst, off) asm volatile("ds_read_b64_tr_b16 %0, %1 offset:%2" : "=&v"(dst) : "v"(vb0), "i"(off) : "memory")
#define MK8(l, h) __builtin_bit_cast(f16x8, __builtin_shufflevector(l, h, 0, 1, 2, 3, 4, 5, 6, 7))
#define PV_D0(d0) do { s16x4 l0, l1, l2, l3, h0, h1, h2, h3; constexpr int b_ = VB * SHM_V + v_rd_off(d0, 0, 0);   \
        TRRD(l0, b_); TRRD(h0, b_ + 2048); TRRD(l1, b_ + 4096); TRRD(h1, b_ + 6144); TRRD(l2, b_ + 8192); TRRD(h2, b_ + 10240); TRRD(l3, b_ + 12288); TRRD(h3, b_ + 14336); \
        asm volatile("s_waitcnt lgkmcnt(0)" ::: "memory"); SBAR();                                                   \
        o[d0] = __builtin_amdgcn_mfma_f32_32x32x16_f16(pa0, MK8(l0, h0), o[d0], 0, 0, 0);   \
        o[d0] = __builtin_amdgcn_mfma_f32_32x32x16_f16(pa1, MK8(l1, h1), o[d0], 0, 0, 0);   \
        o[d0] = __builtin_amdgcn_mfma_f32_32x32x16_f16(pa2, MK8(l2, h2), o[d0], 0, 0, 0);   \
        o[d0] = __builtin_amdgcn_mfma_f32_32x32x16_f16(pa3, MK8(l3, h3), o[d0], 0, 0, 0); } while (0)
    PV_D0(0); PV_D0(1); PV_D0(2); PV_D0(3);
#undef PV_D0
#undef MK8
#undef TRRD
}

struct BlockRef { const h16* Q; const h16* K; const h16* V; h16* O; const h16* KP; const float* BI; int P0; };
template <int MODE> struct Seam { f16x8 qr[Cfg<MODE>::NQF]; f16x8 st_v0, st_v1, st_k0, st_k1, st_p; float st_b; };

#define VMW() asm volatile("s_waitcnt vmcnt(0)" ::: "memory")
#define VMWN(n) asm volatile("s_waitcnt vmcnt(%0)" :: "i"(n) : "memory")
#define AT_SLOAD(R, k0) do { S.st_v0 = ld8((R).V + (size_t)((k0) + sr) * PV + sc); S.st_v1 = ld8((R).V + (size_t)((k0) + 32 + sr) * PV + sc);              \
                             S.st_k0 = ld8((R).K + (size_t)((k0) + sr) * PK + sc); S.st_k1 = ld8((R).K + (size_t)((k0) + 32 + sr) * PK + sc);              \
                             if constexpr (MODE == 0) S.st_p = ld8((R).KP + (size_t)((k0) + (tid >> 3)) * LATP + (tid & 7) * 8);                         \
                             else S.st_b = (R).BI[(k0) + lane]; } while (0)
#define AT_SWRITE_K(bf) do { *(LAS f16x8*)(K_lds + (bf) * SHM_KMAX + kws) = S.st_k0; *(LAS f16x8*)(K_lds + (bf) * SHM_KMAX + kws + 32 * KROWB) = S.st_k1;     \
                             if constexpr (MODE == 0) *(LAS f16x8*)(K_lds + (bf) * SHM_KMAX + kwp) = S.st_p;                                                \
                             else { if (wid == 0) bias_l[(bf) * 64 + lane] = S.st_b; } } while (0)
#define AT_SWRITE_V(bf) do { *(LAS f16x8*)(V_lds + (bf) * SHM_V + vst0) = S.st_v0; *(LAS f16x8*)(V_lds + (bf) * SHM_V + vst1) = S.st_v1; } while (0)
#define AT_SWRITE(bf) do { AT_SWRITE_V(bf); AT_SWRITE_K(bf); } while (0)

template <int MODE>
__device__ __forceinline__ void attn_prime(const BlockRef& cur, lptr lds, Seam<MODE>& S) {
    constexpr int KROWB = Cfg<MODE>::KROWB, NQF = Cfg<MODE>::NQF, PQ = Cfg<MODE>::PQ, PK = Cfg<MODE>::PK, PV = Cfg<MODE>::PV;
    const int tid = opq_v((int)threadIdx.x), wid = __builtin_amdgcn_readfirstlane(tid >> 6), lane = tid & 63, r32 = lane & 31, hi = lane >> 5;
    const int sr = tid >> 4, sc = (tid & 15) * 8;
    const int kws = sr * KROWB + ((sc * 2) ^ ((sr & 7) << 4));
    const int kwp = (tid >> 3) * KROWB + ((256 + (tid & 7) * 16) ^ (((tid >> 3) & 7) << 4));
    lptr K_lds = lds + OFF_K; LAS float* bias_l = (LAS float*)(lds + OFF_BIAS);
    (void)kwp; (void)bias_l;
#pragma unroll
    for (int d0 = 0; d0 < NQF; ++d0) S.qr[d0] = ld8(cur.Q + (size_t)(wid * QBLK + r32) * PQ + d0 * 16 + hi * 8);
    AT_SLOAD(cur, 0); VMW(); AT_SWRITE_K(0);
    __syncthreads();
}
template <int MODE>
__device__ __forceinline__ void attn_block(const BlockRef& cur, const BlockRef& nxt, lptr lds, Seam<MODE>& S) {
    constexpr int KROWB = Cfg<MODE>::KROWB, NQF = Cfg<MODE>::NQF, PQ = Cfg<MODE>::PQ, PK = Cfg<MODE>::PK, PV = Cfg<MODE>::PV;
    const int tid = opq_v((int)threadIdx.x), wid = __builtin_amdgcn_readfirstlane(tid >> 6), lane = tid & 63, r32 = lane & 31, hi = lane >> 5;
    const int NT = cur.P0 / KVBLK + QB / KVBLK;
    const int qlo = cur.P0 + wid * QBLK;
    const int qeff = (MODE == 0) ? (qlo | 63) : qlo;
    const int qm = ((MODE == 0) ? (qlo | 63) : (qlo + r32)) - 4 * hi;
    lptr V_lds = lds + OFF_V; lptr K_lds = lds + OFF_K;
    LAS float* ws = (LAS float*)(lds + OFF_WS) + wid * 64; LAS float* li_l = ws; LAS float* al_l = ws + 32;
    LAS float* bias_l = (LAS float*)(lds + OFF_BIAS);
    float m_reg = -1e30f, l_reg = 0; f32x16 o[4] = {};
    const int sr = tid >> 4, sc = (tid & 15) * 8, vst0 = v_st(sr, sc), vst1 = v_st(32 + sr, sc);
    const int kws = sr * KROWB + ((sc * 2) ^ ((sr & 7) << 4));
    const int kwp = (tid >> 3) * KROWB + ((256 + (tid & 7) * 16) ^ (((tid >> 3) & 7) << 4));
    (void)kwp; (void)bias_l;
    const int vb0 = (int)(unsigned)(uintptr_t)V_lds + v_rd_base(lane);
#define RESC(a) do { if (__any((a) < 1.f)) { if (hi == 0) al_l[r32] = (a); asm volatile("s_waitcnt lgkmcnt(0)" ::: "memory");              \
                     _Pragma("unroll") for (int d_ = 0; d_ < 4; ++d_) _Pragma("unroll") for (int r = 0; r < 16; ++r) o[d_][r] *= al_l[crow(r, hi)]; } } while (0)
#define KBASE(t) ((t) * KVBLK)
#define BIASADD(P0_, P1_, KBUF) do { if constexpr (MODE == 1) { constexpr float C2 = LOG2E * Cfg<1>::SCALE; const LAS float* bb = bias_l + (KBUF) * 64 + 4 * hi;   \
        _Pragma("unroll") for (int g_ = 0; g_ < 4; ++g_) { const f32x4 ba = *(const LAS f32x4*)(bb + 8 * g_), bc = *(const LAS f32x4*)(bb + 32 + 8 * g_);          \
            _Pragma("unroll") for (int e_ = 0; e_ < 4; ++e_) { P0_[4 * g_ + e_] = fmaf(P0_[4 * g_ + e_], C2, ba[e_]); P1_[4 * g_ + e_] = fmaf(P1_[4 * g_ + e_], C2, bc[e_]); } } } } while (0)
#define MASKT(P0_, P1_, t) do { const int kb_ = KBASE(t); if (kb_ + KVBLK - 1 > qeff) mask_tile(P0_, P1_, qm - kb_); } while (0)
#define SEAM_K0() do { VMWN(NQF); AT_SWRITE_K(0); SBAR(); } while (0)
    f32x16 pA0, pA1, pB0, pB1; float mnA, mnB, alA, alB; f16x8 pa0, pa1, pa2, pa3;
    AT_SWRITE_V(0); SBAR();
    AT_SLOAD(cur, KBASE(1));
    SBAR(); qkt<MODE, 0>(pA0, pA1, K_lds, r32, hi, S.qr);
    BIASADD(pA0, pA1, 0); MASKT(pA0, pA1, 0); partialSM<MODE>(pA0, pA1, m_reg, mnA, alA);
    VMW(); AT_SWRITE(1);
    __syncthreads();
#define HALF_STEP(PX0, PX1, mnX, alX, PY0, PY1, alY, t, KB, VB, SB) do {                                                      \
        SBAR(); qkt<MODE, KB>(PX0, PX1, K_lds, r32, hi, S.qr);                                                                \
        finishSM(PY0, PY1, alY, l_reg, pa0, pa1, pa2, pa3); SBAR();                                                           \
        if ((t) + 1 < NT) { AT_SLOAD(cur, KBASE((t) + 1)); SBAR(); }                                                          \
        pv_tile<VB>(o, vb0, pa0, pa1, pa2, pa3); BIASADD(PX0, PX1, KB); MASKT(PX0, PX1, (t)); partialSM<MODE>(PX0, PX1, m_reg, mnX, alX);   \
        __syncthreads();                                                                                                      \
        if ((t) + 1 < NT) { VMW(); AT_SWRITE(SB); }                                                                           \
        RESC(alX); __syncthreads(); } while (0)
    for (int t = 1; t + 1 < NT; t += 2) {
        HALF_STEP(pB0, pB1, mnB, alB, pA0, pA1, alA, t, 1, 0, 0);
        HALF_STEP(pA0, pA1, mnA, alA, pB0, pB1, alB, t + 1, 0, 1, 1);
    }
    SBAR(); qkt<MODE, 1>(pB0, pB1, K_lds, r32, hi, S.qr); SBAR();
    AT_SLOAD(nxt, 0); SBAR();
#pragma unroll
    for (int d0 = 0; d0 < NQF; ++d0) S.qr[d0] = ld8(nxt.Q + (size_t)(wid * QBLK + r32) * PQ + d0 * 16 + hi * 8);
    SBAR();
    finishSM(pA0, pA1, alA, l_reg, pa0, pa1, pa2, pa3); SBAR();
    pv_tile<0>(o, vb0, pa0, pa1, pa2, pa3);
    BIASADD(pB0, pB1, 1); MASKT(pB0, pB1, NT - 1); partialSM<MODE>(pB0, pB1, m_reg, mnB, alB); __syncthreads(); RESC(alB);
    finishSM(pB0, pB1, alB, l_reg, pa0, pa1, pa2, pa3); SBAR(); pv_tile<1>(o, vb0, pa0, pa1, pa2, pa3);
    SBAR(); SEAM_K0();
    if (hi == 0) li_l[r32] = l_reg; asm volatile("s_waitcnt lgkmcnt(0)" ::: "memory");
    float rli[16];
#pragma unroll
    for (int r = 0; r < 16; ++r) rli[r] = __builtin_amdgcn_rcpf(li_l[crow(r, hi)]);
    h16* Ow = cur.O + (size_t)(wid * QBLK) * D;
#pragma unroll
    for (int r = 0; r < 16; ++r) { const int orow = crow(r, hi);
#pragma unroll
        for (int d0 = 0; d0 < 4; ++d0) { const float v = o[d0][r] * rli[r];
            const float vn = __shfl_xor(v, 1);
            if ((r32 & 1) == 0) *(unsigned*)(Ow + (size_t)orow * D + d0 * 32 + r32) = pkh(v, vn); } }
    __syncthreads();
#undef RESC
#undef KBASE
#undef BIASADD
#undef MASKT
#undef SEAM_K0
#undef HALF_STEP
}
template <int MODE>
__device__ __forceinline__ void attn_block_s(const BlockRef& cur, lptr lds) {
    constexpr int KROWB = Cfg<MODE>::KROWB, NQF = Cfg<MODE>::NQF, PQ = Cfg<MODE>::PQ, PK = Cfg<MODE>::PK, PV = Cfg<MODE>::PV;
    const int tid = opq_v((int)threadIdx.x), wid = __builtin_amdgcn_readfirstlane(tid >> 6), lane = tid & 63, r32 = lane & 31, hi = lane >> 5;
    const int NT = cur.P0 / KVBLK + QB / KVBLK;
    const int qlo = cur.P0 + wid * QBLK;
    const int qeff = (MODE == 0) ? (qlo | 63) : qlo;
    const int qm = ((MODE == 0) ? (qlo | 63) : (qlo + r32)) - 4 * hi;
    lptr V_lds = lds + OFF_V; lptr K_lds = lds + OFF_K;
    LAS float* ws = (LAS float*)(lds + OFF_WS) + wid * 64; LAS float* li_l = ws; LAS float* al_l = ws + 32;
    LAS float* bias_l = (LAS float*)(lds + OFF_BIAS);
    float m_reg = -1e30f, l_reg = 0; f32x16 o[4] = {};
    const int sr = tid >> 4, sc = (tid & 15) * 8, vst0 = v_st(sr, sc), vst1 = v_st(32 + sr, sc);
    const int kws = sr * KROWB + ((sc * 2) ^ ((sr & 15) << 4));
    const int kwp = (tid >> 3) * KROWB + 256 + (((tid & 7) * 16) ^ (((tid >> 3) & 15) << 4));
    (void)kwp; (void)bias_l;
    const int vb0 = (int)(unsigned)(uintptr_t)V_lds + v_rd_base(lane);
    unsigned kbv[8];
#pragma unroll
    for (int dd = 0; dd < 8; ++dd) kbv[dd] = (unsigned)(uintptr_t)K_lds + r32 * KROWB + (((dd * 16 + hi * 8) * 2) ^ ((r32 & 15) << 4));
    Seam<MODE> S;
#pragma unroll
    for (int d0 = 0; d0 < NQF; ++d0) S.qr[d0] = ld8(cur.Q + (size_t)(wid * QBLK + r32) * PQ + d0 * 16 + hi * 8);
    AT_SLOAD(cur, 0); VMW(); AT_SWRITE(0); SBAR();
    AT_SLOAD(cur, KVBLK);
    __syncthreads();
    f32x16 p0, p1; float mn, al; f16x8 pa0, pa1, pa2, pa3;
#define RESC(a) do { if (__any((a) < 1.f)) { if (hi == 0) al_l[r32] = (a); asm volatile("s_waitcnt lgkmcnt(0)" ::: "memory");              \
                     _Pragma("unroll") for (int d_ = 0; d_ < 4; ++d_) _Pragma("unroll") for (int r = 0; r < 16; ++r) o[d_][r] *= al_l[crow(r, hi)]; } } while (0)
#define BIASADD(P0_, P1_, KBUF) do { if constexpr (MODE == 1) { constexpr float C2 = LOG2E * Cfg<1>::SCALE; const LAS float* bb = bias_l + (KBUF) * 64 + 4 * hi;   \
        _Pragma("unroll") for (int g_ = 0; g_ < 4; ++g_) { const f32x4 ba = *(const LAS f32x4*)(bb + 8 * g_), bc = *(const LAS f32x4*)(bb + 32 + 8 * g_);          \
            _Pragma("unroll") for (int e_ = 0; e_ < 4; ++e_) { P0_[4 * g_ + e_] = fmaf(P0_[4 * g_ + e_], C2, ba[e_]); P1_[4 * g_ + e_] = fmaf(P1_[4 * g_ + e_], C2, bc[e_]); } } } } while (0)
#define STEP(t, BUF) do { SBAR(); qkt2<MODE, BUF>(p0, p1, kbv, S.qr);                                                \
        BIASADD(p0, p1, BUF); { const int kb_ = (t) * KVBLK; if (kb_ + KVBLK - 1 > qeff) mask_tile(p0, p1, qm - kb_); }           \
        partialSM<MODE>(p0, p1, m_reg, mn, al); finishSM(p0, p1, al, l_reg, pa0, pa1, pa2, pa3); RESC(al); SBAR();              \
        pv_tile<BUF>(o, vb0, pa0, pa1, pa2, pa3); SBAR();                                                                      \
        if ((t) + 1 < NT) { VMW(); AT_SWRITE((BUF) ^ 1); SBAR(); if ((t) + 2 < NT) AT_SLOAD(cur, ((t) + 2) * KVBLK); }            \
        __syncthreads(); } while (0)
    for (int t = 0; t < NT; t += 2) { STEP(t, 0); STEP(t + 1, 1); }
#undef STEP
#undef BIASADD
#undef RESC
    if (hi == 0) li_l[r32] = l_reg; asm volatile("s_waitcnt lgkmcnt(0)" ::: "memory");
    LAS h16* ost = (LAS h16*)(lds + wid * 8192);
#pragma unroll
    for (int r = 0; r < 16; ++r) { const float rl = __builtin_amdgcn_rcpf(li_l[crow(r, hi)]); const int orow = crow(r, hi);
#pragma unroll
        for (int d0 = 0; d0 < 4; ++d0) ost[orow * 128 + d0 * 32 + r32] = (h16)(o[d0][r] * rl); }
    asm volatile("s_waitcnt lgkmcnt(0)" ::: "memory");
    h16* Ow = cur.O + (size_t)(wid * QBLK) * D;
#pragma unroll
    for (int i = 0; i < 8; ++i) { const int row = (lane >> 4) + 4 * i, ch = lane & 15;
        *(u32x4*)(Ow + (size_t)row * D + ch * 8) = *(const LAS u32x4*)(ost + row * 128 + ch * 8); }
    __syncthreads();
}
#undef AT_SLOAD
#undef AT_SWRITE_K
#undef AT_SWRITE_V
#undef AT_SWRITE
#undef VMW
#undef VMWN

template <int MODE>
__device__ __forceinline__ BlockRef make_ref(int L, int pass, const h16* Qb, const h16* Kb, const h16* Vb, h16* Ob, const h16* KPb, const float* BIb) {
    constexpr int PQ = Cfg<MODE>::PQ, PK = Cfg<MODE>::PK, PV = Cfg<MODE>::PV, HD = (MODE == 0) ? QKD : 128;
    const int bh = L >> 2, x = L & 3, qb = pass ? (7 - x) : x, b = bh >> 4, h = bh & 15;
    BlockRef r;
    r.Q = Qb + ((size_t)b * SEQ + (size_t)qb * QB) * PQ + h * HD;
    r.K = Kb + (size_t)b * SEQ * PK + h * 128;
    r.V = Vb + (size_t)b * SEQ * PV + h * 128;
    r.O = Ob + ((size_t)b * SEQ + (size_t)qb * QB) * D + h * 128;
    r.KP = KPb + (size_t)b * SEQ * LATP;
    r.BI = BIb + (size_t)bh * SEQ;
    r.P0 = qb * QB;
    return r;
}
template <int MODE, bool PIPE>
__device__ __forceinline__ void attn_phase(lptr lds, int first, int stride, const h16* Qb, const h16* Kb, const h16* Vb, h16* Ob, const h16* KPb, const float* BIb) {
    constexpr int total = BATCH * NHEAD * 4;
    int L = first; if (L >= total) return;
    if constexpr (PIPE) {
        int pass = 0;
        BlockRef cur = make_ref<MODE>(L, 0, Qb, Kb, Vb, Ob, KPb, BIb);
        Seam<MODE> S;
        attn_prime<MODE>(cur, lds, S);
        for (;;) {
            const bool more_pass = pass == 0, more_item = L + stride < total, last = !more_pass && !more_item;
            int passn = pass + 1, Ln = L;
            if (!more_pass) { passn = 0; Ln = more_item ? L + stride : L; }
            const BlockRef nxt = last ? cur : make_ref<MODE>(Ln, passn, Qb, Kb, Vb, Ob, KPb, BIb);
            attn_block<MODE>(cur, nxt, lds, S);
            if (last) break;
            cur = nxt; pass = passn; L = Ln;
        }
    } else {
        for (; L < total; L += stride)
            for (int pass = 0; pass < 2; ++pass) { const BlockRef cur = make_ref<MODE>(L, pass, Qb, Kb, Vb, Ob, KPb, BIb); attn_block_s<MODE>(cur, lds); }
    }
}
}

typedef GAS unsigned gu32;
#define RLX_AGENT __ATOMIC_RELAXED, __HIP_MEMORY_SCOPE_AGENT
#define XB_TMO      128
#define XB_XCNT(j)  (256  + 64 * (j))
#define XB_XSUB(j)  (1280 + 64 * (j))
#define XB_XGEN(j)  (2304 + 64 * (j))
#define XB_TOP      3328
#define XB_TOPGEN   3392
#define XCD_BAR_WORDS 3456
#define XB_SPIN_CAP (1u << 18)
__device__ __forceinline__ unsigned xb_ld(unsigned* p)              { return __hip_atomic_load(p, __ATOMIC_RELAXED, __HIP_MEMORY_SCOPE_AGENT); }
__device__ __forceinline__ unsigned xb_add(unsigned* p, unsigned v) { return __hip_atomic_fetch_add(p, v, __ATOMIC_RELAXED, __HIP_MEMORY_SCOPE_AGENT); }
__device__ __forceinline__ unsigned xb_xcc_id() { return (unsigned)__builtin_amdgcn_s_getreg((3 << 11) | 20) & 0xFu; }
#define XB_SPIN(cond, bar) do { unsigned _sp = 0; while (cond) { __builtin_amdgcn_s_sleep(1); \
    if ((++_sp & 255u) == 0u) { if (xb_ld(&(bar)[XB_TMO])) break; if (_sp > XB_SPIN_CAP) { atomicAdd(&(bar)[XB_TMO], 1u); break; } } } } while (0)
struct XcdBarrier { unsigned* bar; unsigned x; volatile LAS unsigned* st; };
__device__ __forceinline__ XcdBarrier xcd_barrier_post(unsigned* bar, volatile LAS unsigned* st) {
    XcdBarrier b; b.bar = bar; b.x = xb_xcc_id(); b.st = st;
    if (threadIdx.x == 0) (void)xb_add(&bar[XB_XCNT(b.x)], 1u);
    return b;
}
__device__ __forceinline__ void xcd_barrier_complete(unsigned* bar, unsigned x, unsigned& nloc, unsigned& nx) {
    const unsigned G = gridDim.x * gridDim.y * gridDim.z;
    unsigned sum, cnt, mine, sp = 0u;
    for (;;) {
        sum = 0u; cnt = 0u; mine = 0u;
#pragma unroll
        for (unsigned j = 0; j < 16; ++j) { const unsigned c = xb_ld(&bar[XB_XCNT(j)]); sum += c; cnt += (c > 0u) ? 1u : 0u; mine = (j == x) ? c : mine; }
        if (sum == G) break;
        __builtin_amdgcn_s_sleep(1);
        if ((++sp & 255u) == 0u) { if (xb_ld(&bar[XB_TMO])) break; if (sp > XB_SPIN_CAP) { atomicAdd(&bar[XB_TMO], 1u); break; } }
    }
    nloc = mine > 0u ? mine : 1u; nx = cnt > 0u ? cnt : 1u;
}
__device__ __forceinline__ void xcd_barrier(const XcdBarrier& b) {
    asm volatile("s_waitcnt vmcnt(0)" ::: "memory");
    __syncthreads();
    if (threadIdx.x == 0) {
        unsigned* bar = b.bar;
        __builtin_amdgcn_s_waitcnt(0);
        unsigned nloc = b.st[0], nx = b.st[1];
        if (nloc == 0u) { xcd_barrier_complete(bar, b.x, nloc, nx); b.st[0] = nloc; b.st[1] = nx; }
        const unsigned old = xb_add(&bar[XB_XSUB(b.x)], 1u);
        const unsigned gen = old / nloc;
        if (old + 1u == (gen + 1u) * nloc) {
            __builtin_amdgcn_fence(__ATOMIC_RELEASE, "agent");
            asm volatile("s_waitcnt vmcnt(0)" ::: "memory");
            const unsigned og = xb_add(&bar[XB_TOP], 1u);
            const unsigned tg = og / nx;
            if (og + 1u == (tg + 1u) * nx) xb_add(&bar[XB_TOPGEN], 1u);
            else XB_SPIN(xb_ld(&bar[XB_TOPGEN]) == tg, bar);
            __builtin_amdgcn_fence(__ATOMIC_ACQUIRE, "agent");
            xb_add(&bar[XB_XGEN(b.x)], 1u);
            asm volatile("s_waitcnt vmcnt(0)" ::: "memory");
        } else {
            XB_SPIN(xb_ld(&bar[XB_XGEN(b.x)]) == gen, bar);
            __builtin_amdgcn_fence(__ATOMIC_ACQUIRE, "agent");
            asm volatile("s_waitcnt vmcnt(0)" ::: "memory");
        }
    }
    __syncthreads();
}

__device__ __forceinline__ float wave_sum(float v) {
#pragma unroll
    for (int o = 1; o < 64; o <<= 1) v += __shfl_xor(v, o);
    return v;
}
constexpr int CVT_SCR = 128 * 33 * 4;
__device__ __forceinline__ void cvt_item(const float* W, int K, int N, h16* WT, int rowmode, const float* kscale, LAS float* scr, int item, int lane) {
    const int nblk = (N + 31) / 32, kb = item / nblk, nb = item % nblk, k0 = 128 * kb, n0 = 32 * nb;
    const bool nok = (n0 + (lane & 31)) < N;
    const float* src = W + (size_t)(k0 + (lane >> 5)) * N + n0 + (lane & 31);
    float r[64];
#pragma unroll
    for (int i = 0; i < 64; ++i) r[i] = nok ? src[(size_t)(2 * i) * N] : 0.f;
#pragma unroll
    for (int i = 0; i < 64; ++i) scr[(2 * i + (lane >> 5)) * 33 + (lane & 31)] = r[i];
    LDS_WAIT(); asm volatile("" ::: "memory");
    const int c = lane & 15;
    const int drow0 = rowmode >= 0 ? rowmode + n0 : 256 * (n0 >> 7) + (rowmode == -2 ? 128 : 0) + (n0 & 127);
    f32x4 s0 = (f32x4){1.f, 1.f, 1.f, 1.f}, s1 = s0;
    if (kscale) { s0 = *(const f32x4*)(kscale + k0 + 8 * c); s1 = *(const f32x4*)(kscale + k0 + 8 * c + 4); }
#pragma unroll
    for (int j = 0; j < 8; ++j) { const int n = (lane >> 4) + 4 * j; const LAS float* s = scr + (8 * c) * 33 + n;
        u32x4 o; o.x = pkh(s[0 * 33] * s0[0], s[1 * 33] * s0[1]); o.y = pkh(s[2 * 33] * s0[2], s[3 * 33] * s0[3]); o.z = pkh(s[4 * 33] * s1[0], s[5 * 33] * s1[1]); o.w = pkh(s[6 * 33] * s1[2], s[7 * 33] * s1[3]);
        *(u32x4*)(WT + (size_t)(drow0 + n) * K + k0 + 8 * c) = o; }
    LDS_WAIT(); asm volatile("" ::: "memory");
}

__device__ __forceinline__ void fgate_rows(LAS unsigned char* lds, const h16* Hb, const h16* WfT, const float* bf, float* LOGF, int row0) {
    const int tid = opq_v((int)threadIdx.x), lane = tid & 63, wave = __builtin_amdgcn_readfirstlane(tid >> 6), fr = lane & 15, fq = lane >> 4;
    f32x4 acc0 = {0.f, 0.f, 0.f, 0.f}, acc1 = acc0;
    const h16* a0 = Hb + (size_t)(row0 + fr) * D + wave * 256 + 8 * fq; const h16* a1 = a0 + (size_t)16 * D;
    const h16* bp = WfT + (size_t)fr * D + wave * 256 + 8 * fq;
#pragma unroll
    for (int ks = 0; ks < 8; ++ks) { const f16x8 b = *(const f16x8*)(bp + 32 * ks), x0 = *(const f16x8*)(a0 + 32 * ks), x1 = *(const f16x8*)(a1 + 32 * ks);
        acc0 = __builtin_amdgcn_mfma_f32_16x16x32_f16(b, x0, acc0, 0, 0, 0); acc1 = __builtin_amdgcn_mfma_f32_16x16x32_f16(b, x1, acc1, 0, 0, 0); }
    LAS float* red = (LAS float*)lds;
    *(LAS f32x4*)(red + wave * 512 + fr * 16 + 4 * fq) = acc0; *(LAS f32x4*)(red + wave * 512 + (16 + fr) * 16 + 4 * fq) = acc1;
    __syncthreads();
    { float z = bf[tid & 15];
#pragma unroll
      for (int w = 0; w < 8; ++w) z += red[w * 512 + tid];
      LOGF[(size_t)(row0 + (tid >> 4)) * 16 + (tid & 15)] = fminf(z, 0.f) - log1pf(expf(-fabsf(z))); }
    __syncthreads();
}

struct Args {
    const float* x; const float* c; const int* pos; const float* ada_w; const float* ada_b;
    const float* ln1_g; const float* ln1_b; const float* ln2_g; const float* ln2_b;
    const float* w1; const float* w3; const float* w2;
    const float* w_down; const float* q_norm; const float* w_uq; const float* kv_norm; const float* w_uk; const float* w_uv; const float* mla_wo;
    const float* fox_win; const float* fox_bf; const float* fox_wo;
    float* out; unsigned char* ws; int ph_lo, ph_hi;
};

constexpr int CVT_T_MLA = 10912, CVT_T_FOX = 12560;
constexpr int CVT_P0E_ODD = 1060, CVT_AE_ODD = 5960;
constexpr int CVT_P0E_2 = 4400;
__device__ __forceinline__ bool cvt_job(const Args& args, h16* Wb, int tl, int k, const float*& src, int& K, int& N, h16*& dst, int& rowmode, const float*& ks) {
    const int j = tl >> 1; int kind;
    if ((tl & 1) == 0) { if (k > 7) return false; kind = k < 5 ? k : k + 2; }
    else { if (k > 4) return false; kind = k < 2 ? 5 + k : k + 5; }
    const int idx = kind < 7 ? j : tl;
    h16* mla = Wb + W_MLA0 + (size_t)idx * W_MLA_SZ; h16* fox = Wb + W_FOX0 + (size_t)idx * W_FOX_SZ; h16* ffn = Wb + W_FFN0 + (size_t)idx * W_FFN_SZ;
    rowmode = 0; ks = nullptr;
    switch (kind) {
        case 0: src = args.w_down + (size_t)idx * D * LATN; K = D; N = LATN; dst = mla; break;
        case 1: src = args.w_uq + (size_t)idx * QL * QN; K = QL; N = QN; dst = mla + W_DOWN_SZ; ks = args.q_norm + idx * QL; break;
        case 2: src = args.w_uk + (size_t)idx * KVL * (NHEAD * NOPE); K = KVL; N = NHEAD * NOPE; dst = mla + W_DOWN_SZ; rowmode = QN; ks = args.kv_norm + idx * KVL; break;
        case 3: src = args.w_uv + (size_t)idx * KVL * (NHEAD * VD); K = KVL; N = NHEAD * VD; dst = mla + W_DOWN_SZ; rowmode = QN + NHEAD * NOPE; ks = args.kv_norm + idx * KVL; break;
        case 4: src = args.mla_wo + (size_t)idx * D * D; K = D; N = D; dst = mla + W_DOWN_SZ + W_UP_SZ; break;
        case 5: src = args.fox_win + (size_t)idx * D * PROJN; K = D; N = PROJN; dst = fox; break;
        case 6: src = args.fox_wo + (size_t)idx * D * D; K = D; N = D; dst = fox + W_IN_SZ; break;
        case 7: src = args.w1 + (size_t)idx * D * FF; K = D; N = FF; dst = ffn; rowmode = -1; break;
        case 8: src = args.w3 + (size_t)idx * D * FF; K = D; N = FF; dst = ffn; rowmode = -2; break;
        default: src = args.w2 + (size_t)idx * FF * D; K = FF; N = D; dst = ffn + W_13_SZ; break;
    }
    return true;
}
__device__ __forceinline__ void convert_span(const Args& args, h16* Wb, int tl, int lo, int hi, int worker, int nworkers, LAS float* scr, int lane) {
    int base = 0;
    for (int k = 0; k < 8; ++k) {
        const float* src; int K, N, rowmode; h16* dst; const float* ks;
        if (!cvt_job(args, Wb, tl, k, src, K, N, dst, rowmode, ks)) break;
        const int n = (K / 128) * ((N + 31) / 32);
        const int a = lo > base ? lo : base, b = hi < base + n ? hi : base + n;
        if (a < b) { int g = lo + worker; if (g < a) g += ((a - g + nworkers - 1) / nworkers) * nworkers;
            for (; g < b; g += nworkers) cvt_item(src, K, N, dst, rowmode, ks, scr, g - base, lane); }
        base += n;
    }
}

__device__ __forceinline__ void ln_phase(int gw, int NGW, int lane, const h16* V, float* Xo, float* ST, h16* Ho, const float* g, const float* bt, const float* modl, int sc_idx, int sh_idx) {
    for (int m = gw; m < M; m += NGW) {
        const f16x8* vr = (const f16x8*)(V + (size_t)m * D) + lane;
        float v[32]; float s = 0.f;
#pragma unroll
        for (int j = 0; j < 4; ++j) { const f16x8 t = vr[64 * j];
#pragma unroll
            for (int e = 0; e < 8; ++e) { v[8 * j + e] = (float)t[e]; s += v[8 * j + e]; } }
        const float mean = wave_sum(s) * (1.f / D); float s2 = 0.f;
#pragma unroll
        for (int i = 0; i < 32; ++i) { v[i] -= mean; s2 += v[i] * v[i]; }
        const float rstd = 1.f / sqrtf(wave_sum(s2) * (1.f / D) + LN_EPS);
        if (ST && lane == 0) { f32x2 ms = {mean, rstd}; *(f32x2*)(ST + (size_t)m * 2) = ms; }
        const int b = m >> 11;
#pragma unroll
        for (int j = 0; j < 4; ++j) { const int col = 8 * lane + 512 * j;
            const f32x4 g0 = *(const f32x4*)(g + col), g1 = *(const f32x4*)(g + col + 4), b0 = *(const f32x4*)(bt + col), b1 = *(const f32x4*)(bt + col + 4);
            f32x4 y0, y1;
#pragma unroll
            for (int e = 0; e < 4; ++e) { y0[e] = v[8 * j + e] * rstd * g0[e] + b0[e]; y1[e] = v[8 * j + 4 + e] * rstd * g1[e] + b1[e]; }
            if (Xo) { *(f32x4*)(Xo + (size_t)m * D + col) = y0; *(f32x4*)(Xo + (size_t)m * D + col + 4) = y1; }
            if (Ho) { const float* scp = modl + (size_t)b * MODW + sc_idx * D + col; const float* shp = modl + (size_t)b * MODW + sh_idx * D + col;
                const f32x4 h0 = y0 * (*(const f32x4*)scp + 1.0f) + *(const f32x4*)shp, h1 = y1 * (*(const f32x4*)(scp + 4) + 1.0f) + *(const f32x4*)(shp + 4);
                *(u32x4*)(Ho + (size_t)m * D + col) = pk8(h0, h1); } }
    }
}

constexpr int NPHASE = 3 + 8 * NLAYER;

__global__ void __launch_bounds__(NWAVES * 64, 2) trunk_fwd(Args args) {
    extern __shared__ __attribute__((aligned(16))) unsigned char lds_raw[];
    LAS unsigned char* lds = (LAS unsigned char*)lds_raw;
    volatile LAS unsigned* MISC = (volatile LAS unsigned*)(lds + MISC_OFF);
    const int G = gridDim.x; const int bx = blockIdx.x; const int vcu = (G % 8 == 0) ? (bx % 8) * (G / 8) + bx / 8 : bx;
    const int NGW = G * NWAVES;
    const bool BGCVT = (G == 256);
#define SITE_IDS() const int tid = opq_v((int)threadIdx.x), lane = tid & 63, wave = __builtin_amdgcn_readfirstlane(tid >> 6), gw = vcu * NWAVES + wave; (void)lane; (void)gw
    unsigned char* ws = args.ws;
    unsigned* ctl = (unsigned*)(ws + WS_CTL);
    float* MOD = (float*)(ws + WS_MOD); float* SSP = (float*)(ws + WS_SSP); float* LOGF = (float*)(ws + WS_LOGF); float* BIAS = (float*)(ws + WS_BIAS);
    float* STATS = (float*)(ws + WS_STATS); float* ROPE = (float*)(ws + WS_ROPE); float* MODP = (float*)(ws + WS_MODP); h16* X = (h16*)(ws + WS_X);
    h16* Hb = (h16*)(ws + WS_H); h16* LAT = (h16*)(ws + WS_LAT); h16* Ob = (h16*)(ws + WS_O); h16* QKV = (h16*)(ws + WS_QKV); h16* HH = (h16*)(ws + WS_HH); h16* Wb = (h16*)(ws + WS_W);
    for (int u = threadIdx.x; u < (LDS_BYTES - LDSCTL_OFF) / 4; u += NWAVES * 64) ((LAS unsigned*)(lds + LDSCTL_OFF))[u] = 0u;
    __syncthreads();
    XcdBarrier bar; bar.bar = ctl + CW_BAR; bar.x = 0; bar.st = nullptr;
    if (!MK_PER_PHASE) bar = xcd_barrier_post(ctl + CW_BAR, MISC + 8);
    const int lo = args.ph_lo, hi = args.ph_hi;
#define IN(k) (lo <= (k) && (k) < hi)
#define NREP(K) ((PROBE_DUP == (K)) ? 2 : 1)
#define REP_FOR(K) _Pragma("unroll") for (int rep = 0; rep < NREP(K); ++rep)
#define REP_DUMMY(K) (NREP(K) == 2 && rep == 0)
#define REP_BAR(K) do { if (rep + 1 < NREP(K)) xcd_barrier(bar); } while (0)
    float* DUMX = (float*)(ws + WS_DUMX); h16* DUMH = (h16*)(ws + WS_DUMH); (void)DUMX; (void)DUMH;
#define SEAM(k) do { if (IN((k) + 1)) { if (MK_PER_PHASE) { } else xcd_barrier(bar); } } while (0)

    if (IN(0)) {
        REP_FOR(1) {
        SITE_IDS();
        LAS float* scr = (LAS float*)(lds + wave * CVT_SCR);
        convert_span(args, Wb, 0, 0, CVT_T_MLA, gw, NGW, scr, lane);
        convert_span(args, Wb, 1, 0, BGCVT ? CVT_P0E_ODD : CVT_T_FOX, gw, NGW, scr, lane);
        convert_span(args, Wb, 2, 0, BGCVT ? CVT_P0E_2 : CVT_T_MLA, gw, NGW, scr, lane);
        convert_span(args, Wb, 3, 0, BGCVT ? CVT_P0E_ODD : CVT_T_FOX, gw, NGW, scr, lane);
        {
            const int gt = vcu * (NWAVES * 64) + tid, NT = G * NWAVES * 64;
            constexpr int ZD = (LATP - LATN) * D / 8, ZI = (PROJNP - 6176) * D / 8;
            for (int i = gt; i < 2 * (ZD + ZI); i += NT) {
                const int j = i / (ZD + ZI), r = i % (ZD + ZI);
                h16* p = (r < ZD) ? Wb + W_MLA0 + (size_t)j * W_MLA_SZ + (size_t)LATN * D + (size_t)r * 8
                                  : Wb + W_FOX0 + (size_t)j * W_FOX_SZ + (size_t)6176 * D + (size_t)(r - ZD) * 8;
                *(u32x4*)p = (u32x4){0u, 0u, 0u, 0u};
            }
        }
        __syncthreads();
        {
            LAS float* cact = (LAS float*)lds;
            LAS f32x4* red = (LAS f32x4*)(lds + 4096);
            for (int u = vcu; u < NLAYER * 12 * 16; u += G) {
                const int l = u / 192, r = u % 192, cb = r / 16, kc = r % 16;
                { const int b = tid >> 7, kk = tid & 127; const float cv = args.c[b * D + kc * 128 + kk]; cact[b * 128 + kk] = cv / (1.0f + __expf(-cv)); }
                __syncthreads();
                const int cg = tid & 255, ks = tid >> 8;
                const float* wp = args.ada_w + ((size_t)l * D + kc * 128 + ks * 64) * MODW + cb * 1024 + 4 * cg;
                f32x4 a0 = {0.f, 0.f, 0.f, 0.f}, a1 = a0, a2 = a0, a3 = a0;
#pragma unroll 8
                for (int kk = 0; kk < 64; ++kk) { const f32x4 w = *(const f32x4*)(wp + (size_t)kk * MODW); const int ki = ks * 64 + kk;
                    a0 += w * cact[ki]; a1 += w * cact[128 + ki]; a2 += w * cact[256 + ki]; a3 += w * cact[384 + ki]; }
                if (ks == 1) { red[cg * 4 + 0] = a0; red[cg * 4 + 1] = a1; red[cg * 4 + 2] = a2; red[cg * 4 + 3] = a3; }
                __syncthreads();
                if (ks == 0) { a0 += red[cg * 4 + 0]; a1 += red[cg * 4 + 1]; a2 += red[cg * 4 + 2]; a3 += red[cg * 4 + 3];
                    float* op = MODP + (((size_t)kc * NLAYER + l) * BATCH) * MODW + cb * 1024 + 4 * cg;
                    *(f32x4*)(op) = a0; *(f32x4*)(op + MODW) = a1; *(f32x4*)(op + 2 * MODW) = a2; *(f32x4*)(op + 3 * MODW) = a3; }
                __syncthreads();
            }
        }
        {
            LAS float* invf = (LAS float*)(lds + 65536);
            if (tid < 32) invf[tid] = (float)exp(-(double)tid * (9.210340371976184 / 32.0));
            __syncthreads();
            const int gt = vcu * (NWAVES * 64) + tid, NT = G * NWAVES * 64;
            for (int e = gt; e < M * 32; e += NT) { const int m = e >> 5, i = e & 31;
                const float ang = (float)args.pos[m] * invf[i];
                const double rev = (double)ang * 0.15915494309189535; const float fr = (float)(rev - rint(rev));
                f32x2 cs; cs[0] = __builtin_amdgcn_cosf(fr); cs[1] = __builtin_amdgcn_sinf(fr);
                *(f32x2*)(ROPE + (size_t)e * 2) = cs; }
            __syncthreads();
        }
        REP_BAR(1); }
        SEAM(0);
    }
    if (IN(1)) {
        SITE_IDS();
        const int gt = vcu * (NWAVES * 64) + tid, NT = G * NWAVES * 64;
        for (int e = gt; e < NLAYER * BATCH * MODW; e += NT) { const int l = e / (BATCH * MODW), n = e % MODW;
            float s = args.ada_b[l * MODW + n];
#pragma unroll
            for (int kc = 0; kc < 16; ++kc) s += MODP[(size_t)kc * NLAYER * BATCH * MODW + e];
            MOD[e] = s; }
        SEAM(1);
    }
    if (IN(2)) {
        SITE_IDS();
        for (int m = gw; m < M; m += NGW) { const int b = m >> 11;
#pragma unroll
            for (int j = 0; j < 8; ++j) { const int col = 4 * lane + 256 * j;
                const f32x4 xv = *(const f32x4*)(args.x + (size_t)m * D + col);
                const f32x4 sc = *(const f32x4*)(MOD + (size_t)b * MODW + 1 * D + col), sh = *(const f32x4*)(MOD + (size_t)b * MODW + 0 * D + col);
                const f32x4 hv = xv * (sc + 1.0f) + sh; u32x2 w; w.x = pkh(hv[0], hv[1]); w.y = pkh(hv[2], hv[3]);
                *(u32x2*)(Hb + (size_t)m * D + col) = w; } }
        SEAM(2);
    }

    for (int l_ = 0; l_ < NLAYER; ++l_) {
        const int l = opq_s(l_);
        const int pb = 3 + 8 * l, j = l >> 1;
        const float* modl = MOD + (size_t)l * BATCH * MODW;
        h16* W13 = Wb + W_FFN0 + (size_t)l * W_FFN_SZ; h16* W2 = W13 + W_13_SZ;
        if ((l & 1) == 0) {
            h16* Wd = Wb + W_MLA0 + (size_t)j * W_MLA_SZ; h16* Wu = Wd + W_DOWN_SZ; h16* Wo = Wu + W_UP_SZ;
            h16* Qb = QKV; h16* KVb = QKV + (size_t)M * QN;
            if (IN(pb + 0)) {
                REP_FOR(2) {
                pg8::Gemm g{Hb, Wd, M, LATP, D, D, 1 << 30, 0}; pg8::StaticOrder S; S.init(M, LATP, G, bx);
                pg8::EpiDown E{LAT, SSP, ROPE};
                pg8::gemm_phase<pg8::EpiDown, pg8::StaticOrder, true, true>(lds, g, S, E);
                if (BGCVT && bx >= 160) { SITE_IDS(); convert_span(args, Wb, l + 1, CVT_P0E_ODD, CVT_AE_ODD, (bx - 160) * NWAVES + wave, (G - 160) * NWAVES, (LAS float*)(lds + wave * CVT_SCR), lane); }
                REP_BAR(2); }
                SEAM(pb + 0);
            }
            if (IN(pb + 1)) {
                REP_FOR(3) {
                pg8::Gemm g{LAT, Wu, M, UPN, QL, LATP, 12, QL}; pg8::StaticOrder S; S.init(M, UPN, G, bx);
                pg8::EpiUp E{Qb, KVb, SSP, ROPE};
                pg8::gemm_phase<pg8::EpiUp, pg8::StaticOrder, true, true>(lds, g, S, E);
                REP_BAR(3); }
                SEAM(pb + 1);
            }
            if (IN(pb + 2)) {
                REP_FOR(4) {
                att::attn_phase<0, false>((att::lptr)lds, vcu, G, Qb, KVb, KVb + NHEAD * NOPE, Ob, LAT + QL + KVL, BIAS);
                REP_BAR(4); }
                SEAM(pb + 2);
            }
            if (IN(pb + 3)) {
                REP_FOR(5) {
                pg8::Gemm g{Ob, Wo, M, D, D, D, 1 << 30, 0}; pg8::StaticOrder S; S.init(M, D, G, bx);
                pg8::EpiRes E{(l == 0) ? args.x : nullptr, X, REP_DUMMY(5) ? DUMH : X, modl + 2 * D, STATS, args.ln2_g + (l - 1) * D, args.ln2_b + (l - 1) * D};
                pg8::gemm_phase<pg8::EpiRes, pg8::StaticOrder, true, true>(lds, g, S, E);
                REP_BAR(5); }
                SEAM(pb + 3);
            }
        } else {
            h16* Wi = Wb + W_FOX0 + (size_t)j * W_FOX_SZ; h16* Wo = Wi + W_IN_SZ;
            if (IN(pb + 0)) {
                REP_FOR(6) {
                pg8::Gemm g{Hb, Wi, M, PROJP, D, D, 1 << 30, 0}; pg8::StaticOrder S; S.init(M, PROJP, G, bx);
                pg8::EpiProj E{QKV};
                pg8::gemm_phase<pg8::EpiProj, pg8::StaticOrder, true, true>(lds, g, S, E);
                for (int rb = vcu; rb < M / 32; rb += G) fgate_rows(lds, Hb, Wi + (size_t)PROJP * D, args.fox_bf + j * NHEAD, LOGF, rb * 32);
                REP_BAR(6); }
                SEAM(pb + 0);
            }
            if (IN(pb + 1)) {
                SITE_IDS();
                LAS float* wsum = (LAS float*)lds;
                for (int u = bx; u < BATCH * NHEAD; u += G) { const int b = u >> 4, h = u & 15;
                    float v[4];
#pragma unroll
                    for (int q = 0; q < 4; ++q) v[q] = LOGF[((size_t)b * SEQ + 4 * tid + q) * 16 + h];
                    v[1] += v[0]; v[2] += v[1]; v[3] += v[2];
                    float inc = v[3];
#pragma unroll
                    for (int d = 1; d < 64; d <<= 1) { const float t = __shfl_up(inc, d); if (lane >= d) inc += t; }
                    if (lane == 63) wsum[wave] = inc;
                    __syncthreads();
                    float base = inc - v[3];
                    for (int w = 0; w < wave; ++w) base += wsum[w];
                    f32x4 o; o[0] = -(base + v[0]) * LOG2E; o[1] = -(base + v[1]) * LOG2E; o[2] = -(base + v[2]) * LOG2E; o[3] = -(base + v[3]) * LOG2E;
                    *(f32x4*)(BIAS + (size_t)u * SEQ + 4 * tid) = o;
                    __syncthreads(); }
                SEAM(pb + 1);
            }
            if (IN(pb + 2)) {
                REP_FOR(7) {
                att::attn_phase<1, false>((att::lptr)lds, vcu, G, QKV, QKV + D, QKV + 2 * D, Ob, LAT, BIAS);
                REP_BAR(7); }
                SEAM(pb + 2);
            }
            if (IN(pb + 3)) {
                REP_FOR(5) {
                pg8::Gemm g{Ob, Wo, M, D, D, D, 1 << 30, 0}; pg8::StaticOrder S; S.init(M, D, G, bx);
                pg8::EpiRes E{(l == 0) ? args.x : nullptr, X, REP_DUMMY(5) ? DUMH : X, modl + 2 * D, STATS, args.ln2_g + (l - 1) * D, args.ln2_b + (l - 1) * D};
                pg8::gemm_phase<pg8::EpiRes, pg8::StaticOrder, true, true>(lds, g, S, E);
                REP_BAR(5); }
                SEAM(pb + 3);
            }
        }
        if (IN(pb + 4)) {
            REP_FOR(8) {
            SITE_IDS();
            ln_phase(gw, NGW, lane, X, nullptr, REP_DUMMY(8) ? DUMX : STATS, REP_DUMMY(8) ? DUMH : Hb, args.ln1_g + l * D, args.ln1_b + l * D, modl, 4, 3);
            REP_BAR(8); }
            SEAM(pb + 4);
        }
        if (IN(pb + 5)) {
            REP_FOR(9) {
            pg8::Gemm g{Hb, W13, M, 2 * FF, D, D, 1 << 30, 0}; pg8::StaticOrder S; S.init(M, 2 * FF, G, bx);
            pg8::EpiSwiglu E{HH};
            pg8::gemm_phase<pg8::EpiSwiglu, pg8::StaticOrder, true, true>(lds, g, S, E);
            if (BGCVT && bx >= 128 && l + 1 < NLAYER) { SITE_IDS(); const bool odd = ((l + 1) & 1) != 0;
                convert_span(args, Wb, l + 1, odd ? CVT_AE_ODD : CVT_P0E_2, odd ? CVT_T_FOX : CVT_T_MLA, (bx - 128) * NWAVES + wave, (G - 128) * NWAVES, (LAS float*)(lds + wave * CVT_SCR), lane); }
            REP_BAR(9); }
            SEAM(pb + 5);
        }
        if (IN(pb + 6)) {
            REP_FOR(10) {
            pg8::Gemm g{HH, W2, M, D, FF, FF, 1 << 30, 0}; pg8::StaticOrder S; S.init(M, D, G, bx);
            pg8::EpiRes E{nullptr, X, REP_DUMMY(10) ? DUMH : X, modl + 5 * D, STATS, args.ln1_g + l * D, args.ln1_b + l * D};
            pg8::gemm_phase<pg8::EpiRes, pg8::StaticOrder, true, true>(lds, g, S, E);
            REP_BAR(10); }
            SEAM(pb + 6);
        }
        if (IN(pb + 7)) {
            REP_FOR(8) {
            SITE_IDS();
            if (l + 1 < NLAYER) ln_phase(gw, NGW, lane, X, nullptr, REP_DUMMY(8) ? DUMX : STATS, REP_DUMMY(8) ? DUMH : Hb, args.ln2_g + l * D, args.ln2_b + l * D, modl + (size_t)BATCH * MODW, 1, 0);
            else ln_phase(gw, NGW, lane, X, REP_DUMMY(8) ? DUMX : args.out, nullptr, nullptr, args.ln2_g + l * D, args.ln2_b + l * D, modl, 1, 0);
            REP_BAR(8); }
            SEAM(pb + 7);
        }
    }
#undef IN
#undef SEAM
#undef NREP
#undef REP_FOR
#undef REP_DUMMY
#undef REP_BAR
}

extern "C" void kernel_launch(void* const* d_in, const int* in_sizes, int n_in, void* d_out, int out_size, void* d_ws, size_t ws_size, hipStream_t stream) {
    static int grid = 0;
    if (grid == 0) {
        if (n_in != 22 || in_sizes[0] != M * D || out_size != M * D || ws_size < WS_END) {
            fprintf(stderr, "kernel_launch: shape/workspace mismatch (n_in %d, in0 %d, out %d, ws %zu, need %zu); nothing launched\n", n_in, n_in > 0 ? in_sizes[0] : -1, out_size, ws_size, (size_t)WS_END); grid = -1; return; }
        int dev = 0, cus = 0, per_cu = 0;
        if (hipGetDevice(&dev) != hipSuccess || hipDeviceGetAttribute(&cus, hipDeviceAttributeMultiprocessorCount, dev) != hipSuccess) { grid = -1; return; }
        if (hipFuncSetAttribute((const void*)trunk_fwd, hipFuncAttributeMaxDynamicSharedMemorySize, LDS_BYTES) != hipSuccess) { fprintf(stderr, "kernel_launch: hipFuncSetAttribute failed\n"); grid = -1; return; }
        if (hipOccupancyMaxActiveBlocksPerMultiprocessor(&per_cu, (const void*)trunk_fwd, NWAVES * 64, LDS_BYTES) != hipSuccess || per_cu < 1)
            fprintf(stderr, "kernel_launch: note: occupancy query reports %d workgroups per CU\n", per_cu);
        (void)hipGetLastError();
        grid = cus;
    }
    if (grid < 0) return;
    if (hipMemsetAsync((char*)d_ws + WS_CTL, 0, CTL_ZERO_BYTES, stream) != hipSuccess) return;
    Args a{};
    a.x = (const float*)d_in[0]; a.c = (const float*)d_in[1]; a.pos = (const int*)d_in[2]; a.ada_w = (const float*)d_in[3]; a.ada_b = (const float*)d_in[4];
    a.ln1_g = (const float*)d_in[5]; a.ln1_b = (const float*)d_in[6]; a.ln2_g = (const float*)d_in[7]; a.ln2_b = (const float*)d_in[8];
    a.w1 = (const float*)d_in[9]; a.w3 = (const float*)d_in[10]; a.w2 = (const float*)d_in[11];
    a.w_down = (const float*)d_in[12]; a.q_norm = (const float*)d_in[13]; a.w_uq = (const float*)d_in[14]; a.kv_norm = (const float*)d_in[15];
    a.w_uk = (const float*)d_in[16]; a.w_uv = (const float*)d_in[17]; a.mla_wo = (const float*)d_in[18];
    a.fox_win = (const float*)d_in[19]; a.fox_bf = (const float*)d_in[20]; a.fox_wo = (const float*)d_in[21];
    a.out = (float*)d_out; a.ws = (unsigned char*)d_ws;
#if MK_PER_PHASE
    for (int p = 0; p < NPHASE; ++p) { a.ph_lo = p; a.ph_hi = p + 1; hipLaunchKernelGGL(trunk_fwd, dim3(grid), dim3(NWAVES * 64), LDS_BYTES, stream, a); }
#else
    a.ph_lo = 0; a.ph_hi = NPHASE;
    hipLaunchKernelGGL(trunk_fwd, dim3(grid), dim3(NWAVES * 64), LDS_BYTES, stream, a);
#endif
    const hipError_t le = hipPeekAtLastError();
    if (le != hipSuccess) fprintf(stderr, "kernel_launch: launch failed: %s\n", hipGetErrorName(le));
}
```
